# Optimizing an MI355X kernel written in HIP

```python
import math
import jax, jax.numpy as jnp
from jax import lax
import numpy as np

D_MODEL = 1024
BATCH = 16
SEQ = 4096
DEPTH = 1

CHUNK = 64
D_MIX = D_MODEL
POOL_WIDTH = D_MIX // 2
POOL_WINDOWS = (2, 4, 8, 16)
POOL_GROUPS = len(POOL_WINDOWS)
POOL_GW = POOL_WIDTH // POOL_GROUPS
HGRN_WIDTH = D_MIX - POOL_WIDTH
HGRN_HEADS = 4
HGRN_DK = HGRN_WIDTH // HGRN_HEADS
HGRN_DV = HGRN_WIDTH // HGRN_HEADS
IN_COLS = POOL_WIDTH + 2 * HGRN_HEADS * HGRN_DK + 2 * HGRN_HEADS * HGRN_DV
N_MEM = 256
XATTN_HEADS = 4
XATTN_HD = D_MODEL // XATTN_HEADS
D_FF = 4 * D_MODEL
EPS = 1e-6

kernel_name = "hybrid_pool_hgrn2_xattn_block"


def rmsnorm(x, gain):
    xf = x.astype(jnp.float32)
    y = xf * lax.rsqrt(jnp.mean(xf * xf, axis=-1, keepdims=True) + EPS)
    return (y * gain.astype(jnp.float32)).astype(x.dtype)


def pool_mixer(u, w_grp, scale):
    B, S, P = u.shape
    uf = u.astype(jnp.float32)
    cs = jnp.concatenate([jnp.zeros((B, 1, P), jnp.float32), jnp.cumsum(uf, axis=1)], axis=1)
    t = jnp.arange(S)
    outs = []
    for g, w in enumerate(POOL_WINDOWS):
        sl = slice(g * POOL_GW, (g + 1) * POOL_GW)
        lo = jnp.maximum(t + 1 - w, 0)
        win_sum = cs[:, 1:, sl] - cs[:, lo, sl]
        cnt = jnp.minimum(t + 1, w).astype(jnp.float32)[None, :, None]
        outs.append(win_sum / cnt - uf[..., sl])
    y = jnp.stack(outs, axis=2).astype(u.dtype)
    y = jnp.einsum('bsgc,gcd->bsgd', y, w_grp).reshape(B, S, P)
    return y * scale


def hgrn2_chunkwise(q, log_f, k, v):
    B, S, H, DK = q.shape
    DV = v.shape[-1]
    n = S // CHUNK

    def to_chunks(a):
        return a.reshape(B, n, CHUNK, H, a.shape[-1]).transpose(0, 1, 3, 2, 4)

    q, log_f, k, v = map(to_chunks, (q, log_f, k, v))
    G = jnp.cumsum(log_f, axis=3)
    G_last = G[:, :, :, -1:]
    G_mid = G[:, :, :, CHUNK // 2 - 1:CHUNK // 2]

    q_rel = q * jnp.exp(G - G_mid)
    k_rel = k * jnp.exp(G_mid - G)
    scores = jnp.einsum('bnhtk,bnhsk->bnhts', q_rel, k_rel)
    causal = jnp.tril(jnp.ones((CHUNK, CHUNK), dtype=bool))
    scores = jnp.where(causal, scores, jnp.zeros_like(scores))
    o_intra = jnp.einsum('bnhts,bnhsv->bnhtv', scores, v)

    k_end = k * jnp.exp(G_last - G)
    dS = jnp.einsum('bnhsk,bnhsv->bnhkv', k_end, v)
    decay = jnp.exp(G_last[:, :, :, 0, :])

    def step(state, inp):
        dS_c, d_c = inp
        return d_c[..., None] * state + dS_c, state

    S0 = jnp.zeros((B, H, DK, DV), q.dtype)
    _, S_prev = lax.scan(step, S0, (dS.transpose(1, 0, 2, 3, 4), decay.transpose(1, 0, 2, 3)))
    S_prev = S_prev.transpose(1, 0, 2, 3, 4)
    o_inter = jnp.einsum('bnhtk,bnhkv->bnhtv', q * jnp.exp(G), S_prev)
    o = o_intra + o_inter
    return o.transpose(0, 1, 3, 2, 4).reshape(B, S, H, DV)


def hgrn2_mixer(z, lb_theta, layer, o_norm):
    B, S, _ = z.shape
    hk = HGRN_HEADS * HGRN_DK
    hv = HGRN_HEADS * HGRN_DV
    zq, zf, zi, zg = jnp.split(z, [hk, 2 * hk, 2 * hk + hv], axis=-1)
    p = jax.nn.softmax(lb_theta.astype(jnp.float32), axis=0)
    lb = jnp.cumsum(p, axis=0)[layer]
    f = lb + (1.0 - lb) * jax.nn.sigmoid(zf.astype(jnp.float32))
    log_f = jnp.log(f).astype(z.dtype)
    k = (1.0 - f).astype(z.dtype)
    q = jax.nn.silu(zq)
    shp = (B, S, HGRN_HEADS, -1)
    o = hgrn2_chunkwise(q.reshape(shp), log_f.reshape(shp), k.reshape(shp), zi.reshape(shp))
    o = rmsnorm(o, o_norm.reshape(HGRN_HEADS, HGRN_DV))
    return o.reshape(B, S, hv) * jax.nn.silu(zg)


def cross_attention(h, mem, wq, wkv, wo):
    B, S, _ = h.shape
    q = (h @ wq).reshape(B, S, XATTN_HEADS, XATTN_HD)
    kv = mem @ wkv
    k, v = jnp.split(kv, 2, axis=-1)
    k = k.reshape(B, N_MEM, XATTN_HEADS, XATTN_HD)
    v = v.reshape(B, N_MEM, XATTN_HEADS, XATTN_HD)
    s = jnp.einsum('bshd,bmhd->bhsm', q, k).astype(jnp.float32) / math.sqrt(XATTN_HD)
    p = jax.nn.softmax(s, axis=-1).astype(h.dtype)
    o = jnp.einsum('bhsm,bmhd->bshd', p, v).reshape(B, S, D_MODEL)
    return o @ wo


def setup_inputs(seed: int = 0) -> dict:
    key = jax.random.key(seed)
    ks = jax.random.split(key, 24)
    n = jax.random.normal
    L = DEPTH
    return {
        "x": n(ks[0], (BATCH, SEQ, D_MODEL), jnp.float32),
        "mem": n(ks[1], (BATCH, N_MEM, D_MODEL), jnp.float32),
        "norm_mix": 1.0 + 0.02 * n(ks[2], (L, D_MODEL), jnp.float32),
        "w_in": n(ks[3], (L, D_MODEL, IN_COLS), jnp.float32) * D_MODEL ** -0.5,
        "pool_w": n(ks[4], (L, POOL_GROUPS, POOL_GW, POOL_GW), jnp.float32) * POOL_GW ** -0.5,
        "pool_scale": 1.0 + 0.02 * n(ks[5], (L, POOL_WIDTH), jnp.float32),
        "lb_theta": 0.1 * n(ks[6], (L + 1, HGRN_HEADS * HGRN_DK), jnp.float32),
        "hgrn_norm": 1.0 + 0.02 * n(ks[7], (L, HGRN_HEADS * HGRN_DV), jnp.float32),
        "w_out": n(ks[8], (L, D_MIX, D_MODEL), jnp.float32) * D_MIX ** -0.5,
        "norm_xq": 1.0 + 0.02 * n(ks[9], (L, D_MODEL), jnp.float32),
        "norm_mem": 1.0 + 0.02 * n(ks[10], (L, D_MODEL), jnp.float32),
        "xw_q": n(ks[11], (L, D_MODEL, D_MODEL), jnp.float32) * D_MODEL ** -0.5,
        "xw_kv": n(ks[12], (L, D_MODEL, 2 * D_MODEL), jnp.float32) * D_MODEL ** -0.5,
        "xw_o": n(ks[13], (L, D_MODEL, D_MODEL), jnp.float32) * D_MODEL ** -0.5,
        "norm_mlp": 1.0 + 0.02 * n(ks[14], (L, D_MODEL), jnp.float32),
        "w_up": n(ks[15], (L, D_MODEL, D_FF), jnp.float32) * D_MODEL ** -0.5,
        "w_down": n(ks[16], (L, D_FF, D_MODEL), jnp.float32) * D_FF ** -0.5,
        "norm_final": 1.0 + 0.02 * n(ks[17], (D_MODEL,), jnp.float32),
    }


def reference(x, mem, norm_mix, w_in, pool_w, pool_scale, lb_theta, hgrn_norm, w_out,
              norm_xq, norm_mem, xw_q, xw_kv, xw_o, norm_mlp, w_up, w_down, norm_final):
    h = x
    for l in range(DEPTH):
        u = rmsnorm(h, norm_mix[l]) @ w_in[l]
        u_pool, u_hgrn = u[..., :POOL_WIDTH], u[..., POOL_WIDTH:]
        y_pool = pool_mixer(u_pool, pool_w[l], pool_scale[l])
        y_hgrn = hgrn2_mixer(u_hgrn, lb_theta, l, hgrn_norm[l])
        h = h + jnp.concatenate([y_pool, y_hgrn], axis=-1) @ w_out[l]
        h = h + cross_attention(rmsnorm(h, norm_xq[l]), rmsnorm(mem, norm_mem[l]),
                                xw_q[l], xw_kv[l], xw_o[l])
        a = jax.nn.relu(rmsnorm(h, norm_mlp[l]) @ w_up[l])
        h = h + (a * a) @ w_down[l]
    return rmsnorm(h, norm_final)
```

```cpp
#include <hip/hip_runtime.h>
#include <hip/hip_cooperative_groups.h>
#include <cstdio>
#include <cstdint>
namespace cg = cooperative_groups;
namespace pg8 {
#define PG8_LAS __attribute__((address_space(3)))
typedef unsigned short bf16_t;
typedef short bf16x8 __attribute__((ext_vector_type(8)));
typedef float f32x4 __attribute__((ext_vector_type(4)));
typedef unsigned u32x4 __attribute__((ext_vector_type(4)));
constexpr int BM = 256, BK = 64, HALF = 128, HTB = HALF * BK * 2  , STAGE_BYTES = 8 * HTB, NXCD = 8, WGM = 8;

__host__ __device__ __forceinline__ int lds_byte(int r, int c) { const int st = (r >> 4) * 2 + (c >> 5), rr = r & 15, cc = c & 31, ob = rr * 64 + cc * 2; return st * 1024 + (ob ^ (((ob >> 9) & 1) << 5)); }
__host__ __device__ __forceinline__ void stage_rc(int b, int& R, int& C) { const int st = b / 1024, sb = b % 1024, swz = sb ^ (((sb >> 9) & 1) << 5); R = (st >> 1) * 16 + swz / 64; C = (st & 1) * 32 + (swz % 64) / 2; }
__host__ __device__ __forceinline__ int perm32(int rho) { const int n = rho >> 4, i = rho & 15; return 8 * (i >> 2) + 4 * n + (i & 3); }

struct Unit { int pm, pn; };
struct Gemm { const bf16_t* A; const bf16_t* Bt; int M, N, K; };

struct StaticOrder {
    int nM, nN, nwg, G, c;
    __host__ __device__ void init(int M, int N, int G_, int c_) { nM = M / BM; nN = N / BM; nwg = nM * nN; G = G_; c = c_; }
    __host__ __device__ bool next(int i, Unit& u) const {
        const long L = (long)i * G + c; if (L >= nwg) return false;
        int wgid = (int)L; { const int q = nwg / NXCD, r = nwg % NXCD, xcd = wgid % NXCD, off = wgid / NXCD; wgid = (xcd < r ? xcd * (q + 1) : r * (q + 1) + (xcd - r) * q) + off; }
        const int nig = WGM * nN, gid = wgid / nig, fm = gid * WGM, gsz = (nM - fm) < WGM ? (nM - fm) : WGM;
        u.pm = fm + ((wgid % nig) % gsz); u.pn = (wgid % nig) / gsz; return true;
    }
    __device__ __forceinline__ void a_ready(const Unit&) const {}
    __device__ __forceinline__ void done(const Unit&) const {}
};

typedef float f32x2c_t __attribute__((ext_vector_type(2))); typedef __bf16 bf16x2c_t __attribute__((ext_vector_type(2)));
__device__ __forceinline__ unsigned cvt_pk_bf16(float lo, float hi) { const f32x2c_t v = {lo, hi}; const bf16x2c_t b = __builtin_convertvector(v, bf16x2c_t); return __builtin_bit_cast(unsigned, b); }
typedef float f32x2 __attribute__((ext_vector_type(2)));
__device__ __forceinline__ float sigmoid_f(float x) { return __builtin_amdgcn_rcpf(1.0f + __expf(-x)); }
__device__ __forceinline__ float silu_f(float x) { return x * sigmoid_f(x); }
__device__ __forceinline__ u32x4 pack8(const f32x4 a, const f32x4 b) { u32x4 w; w.x = cvt_pk_bf16(a[0], a[1]); w.y = cvt_pk_bf16(a[2], a[3]); w.z = cvt_pk_bf16(b[0], b[1]); w.w = cvt_pk_bf16(b[2], b[3]); return w; }

struct EpiU {
    static constexpr bool PERM = true, AFTER_DRAIN = false;
    bf16_t* UP; bf16_t* H; float* LF; const float* rstd; const float* lbt;
    mutable float rsc[8]; mutable int cpm;
    __device__ __forceinline__ void operator()(const f32x4 (&acc)[2][2][4][2], const Unit& u, int wr, int wc, int fr, int fq) const {
        const int row0 = u.pm * BM + wr * 64 + fr, kind = u.pn >> 1, d0 = wc * 32 + 8 * fq;
        if (u.pm != cpm) { cpm = u.pm;
#pragma unroll
            for (int ai = 0; ai < 2; ++ai)
#pragma unroll
                for (int m = 0; m < 4; ++m) rsc[ai * 4 + m] = rstd[row0 + ai * HALF + m * 16]; }
        if (kind == 0) {
#pragma unroll
            for (int ai = 0; ai < 2; ++ai)
#pragma unroll
                for (int m = 0; m < 4; ++m) { const int row = row0 + ai * HALF + m * 16; const float rs = rsc[ai * 4 + m];
#pragma unroll
                    for (int bj = 0; bj < 2; ++bj) *(u32x4*)(UP + (size_t)row * 512 + u.pn * BM + bj * HALF + d0) = pack8(acc[ai][bj][m][0] * rs, acc[ai][bj][m][1] * rs); }
        } else if (kind == 2) {
            f32x4 lb[2][2];
#pragma unroll
            for (int bj = 0; bj < 2; ++bj)
#pragma unroll
                for (int n = 0; n < 2; ++n) { const int c = (u.pn & 1) * BM + bj * HALF + d0 + 4 * n; const f32x4 t0 = *(const f32x4*)(lbt + c), t1 = *(const f32x4*)(lbt + 512 + c);
#pragma unroll
                    for (int e = 0; e < 4; ++e) lb[bj][n][e] = __builtin_amdgcn_rcpf(1.0f + __expf(t1[e] - t0[e])); }
#pragma unroll
            for (int ai = 0; ai < 2; ++ai)
#pragma unroll
                for (int m = 0; m < 4; ++m) { const int row = row0 + ai * HALF + m * 16; const float rs = rsc[ai * 4 + m];
#pragma unroll
                    for (int bj = 0; bj < 2; ++bj) { f32x4 lf[2], kk[2];
#pragma unroll
                        for (int n = 0; n < 2; ++n)
#pragma unroll
                            for (int e = 0; e < 4; ++e) { const float z = acc[ai][bj][m][n][e] * rs, l = lb[bj][n][e], f = l + (1.0f - l) * sigmoid_f(z); lf[n][e] = __logf(f); kk[n][e] = 1.0f - f; }
                        const size_t hoff = ((size_t)((row >> 12) * 4 + (u.pn & 1) * 2 + bj) * 4096 + (row & 4095)) * 128 + d0;
                        float* lp = LF + hoff; *(f32x4*)lp = lf[0]; *(f32x4*)(lp + 4) = lf[1];
                        *(u32x4*)(H + (size_t)1 * 64 * 4096 * 128 + hoff) = pack8(kk[0], kk[1]); } }
        } else {
            const bool act = (kind == 1) || (kind == 4);
            bf16_t* Hk = H + (size_t)(kind - 1) * 64 * 4096 * 128;
#pragma unroll
            for (int ai = 0; ai < 2; ++ai)
#pragma unroll
                for (int m = 0; m < 4; ++m) { const int row = row0 + ai * HALF + m * 16; const float rs = rsc[ai * 4 + m];
#pragma unroll
                    for (int bj = 0; bj < 2; ++bj) { f32x4 v0 = acc[ai][bj][m][0] * rs, v1 = acc[ai][bj][m][1] * rs;
                        if (act) {
#pragma unroll
                            for (int e = 0; e < 4; ++e) { v0[e] = silu_f(v0[e]); v1[e] = silu_f(v1[e]); } }
                        const size_t hoff = ((size_t)((row >> 12) * 4 + (u.pn & 1) * 2 + bj) * 4096 + (row & 4095)) * 128 + d0;
                        *(u32x4*)(Hk + hoff) = pack8(v0, v1); } }
        }
    }
};
template <bool COLSCALE, bool RELU2, bool FROM_SS> struct EpiScale {
    static constexpr bool PERM = true, AFTER_DRAIN = false;
    bf16_t* O; int ldc; const float* sc; float mul;
    __device__ __forceinline__ void operator()(const f32x4 (&acc)[2][2][4][2], const Unit& u, int wr, int wc, int fr, int fq) const {
        const int row0 = u.pm * BM + wr * 64 + fr, col0 = u.pn * BM + wc * 32 + 8 * fq;
        f32x4 cs[2][2];
        if (COLSCALE) {
#pragma unroll
            for (int bj = 0; bj < 2; ++bj)
#pragma unroll
                for (int n = 0; n < 2; ++n) cs[bj][n] = *(const f32x4*)(sc + col0 + bj * HALF + 4 * n) * mul;
        }
#pragma unroll
        for (int ai = 0; ai < 2; ++ai)
#pragma unroll
            for (int m = 0; m < 4; ++m) { const int row = row0 + ai * HALF + m * 16; float rs = 1.0f;
                if (!COLSCALE) { if (FROM_SS) { const f32x4* sp = (const f32x4*)(sc + (size_t)row * 16); const f32x4 p0 = sp[0], p1 = sp[1], p2 = sp[2], p3 = sp[3];
                        const float ssum = ((p0[0] + p0[1]) + (p0[2] + p0[3])) + ((p1[0] + p1[1]) + (p1[2] + p1[3])) + ((p2[0] + p2[1]) + (p2[2] + p2[3])) + ((p3[0] + p3[1]) + (p3[2] + p3[3]));
                        rs = rsqrtf(ssum * (1.0f / 1024.0f) + 1e-6f) * mul; } else rs = sc[row] * mul; }
#pragma unroll
                for (int bj = 0; bj < 2; ++bj) { f32x4 v0, v1;
                    if (COLSCALE) { v0 = acc[ai][bj][m][0] * cs[bj][0]; v1 = acc[ai][bj][m][1] * cs[bj][1]; } else { v0 = acc[ai][bj][m][0] * rs; v1 = acc[ai][bj][m][1] * rs; }
                    if (RELU2) {
#pragma unroll
                        for (int e = 0; e < 4; ++e) { const float a = fmaxf(v0[e], 0.f), b = fmaxf(v1[e], 0.f); v0[e] = a * a; v1[e] = b * b; } }
                    *(u32x4*)(O + (size_t)row * ldc + col0 + bj * HALF) = pack8(v0, v1); } }
    }
};
struct EpiUp {
    static constexpr bool PERM = true, AFTER_DRAIN = false;
    bf16_t* O; const float* sc; mutable float rsc[8]; mutable int cpm;
    __device__ __forceinline__ void operator()(const f32x4 (&acc)[2][2][4][2], const Unit& u, int wr, int wc, int fr, int fq) const {
        const int row0 = u.pm * BM + wr * 64 + fr, col0 = u.pn * BM + wc * 32 + 8 * fq;
        if (u.pm != cpm) { cpm = u.pm;
#pragma unroll
            for (int ai = 0; ai < 2; ++ai)
#pragma unroll
                for (int m = 0; m < 4; ++m) { const int row = row0 + ai * HALF + m * 16; const f32x4* sp = (const f32x4*)(sc + (size_t)row * 16); const f32x4 p0 = sp[0], p1 = sp[1], p2 = sp[2], p3 = sp[3];
                    const float ssum = ((p0[0] + p0[1]) + (p0[2] + p0[3])) + ((p1[0] + p1[1]) + (p1[2] + p1[3])) + ((p2[0] + p2[1]) + (p2[2] + p2[3])) + ((p3[0] + p3[1]) + (p3[2] + p3[3]));
                    rsc[ai * 4 + m] = rsqrtf(ssum * (1.0f / 1024.0f) + 1e-6f); } }
#pragma unroll
        for (int ai = 0; ai < 2; ++ai)
#pragma unroll
            for (int m = 0; m < 4; ++m) { const int row = row0 + ai * HALF + m * 16; const float rs = rsc[ai * 4 + m];
#pragma unroll
                for (int bj = 0; bj < 2; ++bj) { f32x4 v0 = acc[ai][bj][m][0] * rs, v1 = acc[ai][bj][m][1] * rs;
#pragma unroll
                    for (int e = 0; e < 4; ++e) { const float a = fmaxf(v0[e], 0.f), b = fmaxf(v1[e], 0.f); v0[e] = a * a; v1[e] = b * b; }
                    *(u32x4*)(O + (size_t)row * 4096 + col0 + bj * HALF) = pack8(v0, v1); } }
    }
};
template <bool BASE_BF16, bool WRITE_F32, bool WRITE_B> struct EpiResid {
    static constexpr bool PERM = true, AFTER_DRAIN = false;
    const void* base; float* out; bf16_t* ob; float* ss;
    __device__ __forceinline__ void operator()(const f32x4 (&acc)[2][2][4][2], const Unit& u, int wr, int wc, int fr, int fq) const {
        const int row0 = u.pm * BM + wr * 64 + fr, col0 = u.pn * BM + wc * 32 + 8 * fq;
#pragma unroll
        for (int ai = 0; ai < 2; ++ai)
#pragma unroll
            for (int m = 0; m < 4; ++m) { const int row = row0 + ai * HALF + m * 16; float s = 0.f;
#pragma unroll
                for (int bj = 0; bj < 2; ++bj) { const size_t off = (size_t)row * 1024 + col0 + bj * HALF; f32x4 b0, b1;
                    if (BASE_BF16) { const u32x4 w = *(const u32x4*)((const bf16_t*)base + off);
                        b0 = (f32x4){__uint_as_float(w.x << 16), __uint_as_float(w.x & 0xffff0000u), __uint_as_float(w.y << 16), __uint_as_float(w.y & 0xffff0000u)};
                        b1 = (f32x4){__uint_as_float(w.z << 16), __uint_as_float(w.z & 0xffff0000u), __uint_as_float(w.w << 16), __uint_as_float(w.w & 0xffff0000u)}; }
                    else { b0 = *(const f32x4*)((const float*)base + off); b1 = *(const f32x4*)((const float*)base + off + 4); }
                    const f32x4 h0 = b0 + acc[ai][bj][m][0], h1 = b1 + acc[ai][bj][m][1];
                    if (WRITE_F32) { *(f32x4*)(out + off) = h0; *(f32x4*)(out + off + 4) = h1; }
                    s += (h0[0] * h0[0] + h0[1] * h0[1]) + (h0[2] * h0[2] + h0[3] * h0[3]) + (h1[0] * h1[0] + h1[1] * h1[1]) + (h1[2] * h1[2] + h1[3] * h1[3]);
                    if (WRITE_B) *(u32x4*)(ob + off) = pack8(h0, h1); }
                s += __shfl_xor(s, 16); s += __shfl_xor(s, 32);
                if (fq == 0) ss[(size_t)row * 16 + u.pn * 4 + wc] = s; }
    }
};

template <class Epi, class Sched, bool ALIGN_EPI = false, bool SP2 = false>
__device__ __forceinline__ void gemm_phase(PG8_LAS unsigned char* lds, const Gemm g, const Sched& S, const Epi& E) {
    const int tid = threadIdx.x, wid = __builtin_amdgcn_readfirstlane(tid >> 6), lane = tid & 63, wr = wid >> 2, wc = wid & 3, fr = lane & 15, fq = lane >> 4;
    const int K = g.K, nt = K / BK;
    unsigned voffA[2], voffB[2];
#pragma unroll
    for (int i = 0; i < 2; ++i) { int R, C; stage_rc(tid * 16 + i * 8192, R, C); const int Rb = Epi::PERM ? ((R & ~31) + perm32(R & 31)) : R;
        voffA[i] = (unsigned)(R * K + C) * 2u; voffB[i] = (unsigned)(Rb * K + C) * 2u; }
    const size_t kstep = (size_t)(BK * 2);
    const size_t hstep = (size_t)HALF * K * 2;
    const size_t tstep = 2 * hstep;
    const unsigned ldsw = (unsigned)wid * 1024u;
    const int aoff = lds_byte(wr * 64 + fr, fq * 8), boff = lds_byte(wc * 32 + fr, fq * 8);
#define PG8_SA(b, h) (((b) * 2 + (h)) * HTB)
#define PG8_SB(b, h) ((4 + (b) * 2 + (h)) * HTB)
#define PG8_STAGE(bufoff, gbase, voff) do { _Pragma("unroll") for (int _i = 0; _i < 2; ++_i) \
        __builtin_amdgcn_global_load_lds((const unsigned*)((const char*)(gbase) + (voff)[_i]), (PG8_LAS unsigned*)(lds + (bufoff) + ldsw + _i * 8192), 16, 0, 0); } while (0)
#define PG8_LDA(dst, b, h) do { _Pragma("unroll") for (int m = 0; m < 4; ++m) _Pragma("unroll") for (int k = 0; k < 2; ++k) dst[m][k] = *(const PG8_LAS bf16x8*)(lds + PG8_SA(b, h) + aoff + m * 2048 + k * 1024); } while (0)
#define PG8_LDB(dst, b, h) do { _Pragma("unroll") for (int n = 0; n < 2; ++n) _Pragma("unroll") for (int k = 0; k < 2; ++k) dst[n][k] = *(const PG8_LAS bf16x8*)(lds + PG8_SB(b, h) + boff + n * 2048 + k * 1024); } while (0)
#define PG8_MMA(ai, bj, At, Bt) do { __builtin_amdgcn_s_setprio(1); _Pragma("unroll") for (int m = 0; m < 4; ++m) _Pragma("unroll") for (int n = 0; n < 2; ++n) _Pragma("unroll") for (int k = 0; k < 2; ++k) \
        acc[ai][bj][m][n] = __builtin_amdgcn_mfma_f32_16x16x32_bf16(Bt[n][k], At[m][k], acc[ai][bj][m][n], 0, 0, 0); __builtin_amdgcn_s_setprio(0); } while (0)
#define PG8_WAIT_V(n) asm volatile("s_waitcnt vmcnt(" #n ")" ::: "memory")
#define PG8_WAIT_L(n) asm volatile("s_waitcnt lgkmcnt(" #n ")" ::: "memory")
#define PG8_BAR __builtin_amdgcn_s_barrier()
#define PG8_SCHED __builtin_amdgcn_sched_barrier(0)
    Unit cur, nxt; int ui = 0;
    if (!S.next(0, cur)) return;
    f32x4 acc[2][2][4][2];
#pragma unroll
    for (int a = 0; a < 2; ++a)
#pragma unroll
        for (int b = 0; b < 2; ++b)
#pragma unroll
            for (int m = 0; m < 4; ++m)
#pragma unroll
                for (int n = 0; n < 2; ++n) acc[a][b][m][n] = (f32x4){0.f, 0.f, 0.f, 0.f};
    bf16x8 At[4][2], B0[2][2], B1[2][2];
    const char* cA = (const char*)g.A + (size_t)cur.pm * tstep; const char* cB = (const char*)g.Bt + (size_t)cur.pn * tstep;
    S.a_ready(cur);
    if constexpr (SP2) {
        PG8_STAGE(PG8_SB(0, 0), cB, voffB); PG8_STAGE(PG8_SB(0, 1), cB + hstep, voffB); PG8_STAGE(PG8_SA(0, 0), cA, voffA); PG8_STAGE(PG8_SA(0, 1), cA + hstep, voffA);
        if (wr == 1) PG8_BAR;
        PG8_WAIT_V(2); PG8_BAR;
        PG8_STAGE(PG8_SB(1, 0), cB + kstep, voffB); PG8_STAGE(PG8_SA(1, 0), cA + kstep, voffA); PG8_STAGE(PG8_SB(1, 1), cB + hstep + kstep, voffB);
        PG8_WAIT_V(6); PG8_BAR;
    } else {
        PG8_STAGE(PG8_SB(0, 0), cB, voffB); PG8_STAGE(PG8_SA(0, 0), cA, voffA); PG8_STAGE(PG8_SB(0, 1), cB + hstep, voffB); PG8_STAGE(PG8_SA(0, 1), cA + hstep, voffA);
        if (wr == 1) PG8_BAR;
        PG8_WAIT_V(4); PG8_BAR;
        PG8_STAGE(PG8_SB(1, 0), cB + kstep, voffB); PG8_STAGE(PG8_SA(1, 0), cA + kstep, voffA); PG8_STAGE(PG8_SB(1, 1), cB + hstep + kstep, voffB);
        PG8_WAIT_V(6); PG8_BAR;
    }
    for (;;) {
        const bool has_next = S.next(ui + 1, nxt);
        const char* nA = has_next ? (const char*)g.A + (size_t)nxt.pm * tstep : cA; const char* nB = has_next ? (const char*)g.Bt + (size_t)nxt.pn * tstep : cB;
        for (int t = 0; t < nt; t += 2) {
            const bool last = (t == nt - 2);
            const char* a1 = cA + (size_t)(t + 1) * kstep;
            const char* a2 = last ? nA : cA + (size_t)(t + 2) * kstep; const char* b2 = last ? nB : cB + (size_t)(t + 2) * kstep;
            const char* a3 = a2 + kstep; const char* b3 = b2 + kstep;
            if (last && has_next) S.a_ready(nxt);
            if constexpr (SP2) {
            PG8_LDB(B0, 0, 0); PG8_LDB(B1, 0, 1); PG8_SCHED; PG8_LDA(At, 0, 0); PG8_STAGE(PG8_SA(1, 1), a1 + hstep, voffA);
            PG8_WAIT_V(8); PG8_WAIT_L(0); PG8_BAR; PG8_MMA(0, 0, At, B0); PG8_MMA(0, 1, At, B1); PG8_BAR; PG8_SCHED;
            PG8_LDA(At, 0, 1); PG8_STAGE(PG8_SB(0, 0), b2, voffB); PG8_STAGE(PG8_SB(0, 1), b2 + hstep, voffB); PG8_STAGE(PG8_SA(0, 0), a2, voffA);
            PG8_WAIT_V(8); PG8_WAIT_L(0); PG8_BAR; PG8_MMA(1, 0, At, B0); PG8_MMA(1, 1, At, B1); PG8_BAR; PG8_SCHED;
            PG8_LDB(B0, 1, 0); PG8_LDB(B1, 1, 1); PG8_SCHED; PG8_LDA(At, 1, 0); PG8_STAGE(PG8_SA(0, 1), a2 + hstep, voffA);
            PG8_WAIT_V(8); PG8_WAIT_L(0); PG8_BAR; PG8_MMA(0, 0, At, B0); PG8_MMA(0, 1, At, B1); PG8_BAR; PG8_SCHED;
            PG8_LDA(At, 1, 1); PG8_STAGE(PG8_SB(1, 0), b3, voffB); PG8_STAGE(PG8_SB(1, 1), b3 + hstep, voffB); PG8_STAGE(PG8_SA(1, 0), a3, voffA);
            PG8_WAIT_V(8); PG8_WAIT_L(0); PG8_BAR; PG8_MMA(1, 0, At, B0); PG8_MMA(1, 1, At, B1); PG8_BAR; PG8_SCHED;
            } else {
            PG8_LDB(B0, 0, 0); PG8_SCHED; PG8_LDA(At, 0, 0); PG8_STAGE(PG8_SA(1, 1), a1 + hstep, voffA);
            PG8_WAIT_L(8); PG8_BAR; PG8_WAIT_L(0); PG8_MMA(0, 0, At, B0); PG8_BAR; PG8_SCHED;
            PG8_LDB(B1, 0, 1); PG8_STAGE(PG8_SB(0, 0), b2, voffB);
            PG8_BAR; PG8_WAIT_L(0); PG8_MMA(0, 1, At, B1); PG8_BAR;
            PG8_LDA(At, 0, 1); PG8_STAGE(PG8_SA(0, 0), a2, voffA);
            PG8_BAR; PG8_WAIT_L(0); PG8_MMA(1, 0, At, B0); PG8_BAR; PG8_SCHED;
            PG8_STAGE(PG8_SB(0, 1), b2 + hstep, voffB);
            PG8_WAIT_V(6); PG8_BAR; PG8_MMA(1, 1, At, B1); PG8_BAR;
            PG8_LDB(B0, 1, 0); PG8_SCHED; PG8_LDA(At, 1, 0); PG8_STAGE(PG8_SA(0, 1), a2 + hstep, voffA);
            PG8_WAIT_L(8); PG8_BAR; PG8_WAIT_L(0); PG8_MMA(0, 0, At, B0); PG8_BAR; PG8_SCHED;
            PG8_LDB(B1, 1, 1); PG8_STAGE(PG8_SB(1, 0), b3, voffB);
            PG8_BAR; PG8_WAIT_L(0); PG8_MMA(0, 1, At, B1); PG8_BAR;
            PG8_LDA(At, 1, 1); PG8_STAGE(PG8_SA(1, 0), a3, voffA);
            PG8_BAR; PG8_WAIT_L(0); PG8_MMA(1, 0, At, B0); PG8_BAR; PG8_SCHED;
            PG8_STAGE(PG8_SB(1, 1), b3 + hstep, voffB);
            PG8_WAIT_V(6); PG8_BAR; PG8_MMA(1, 1, At, B1); PG8_BAR;
            }
        }
        if constexpr (ALIGN_EPI) { if (wr == 0) PG8_BAR; }
        if constexpr (!Epi::AFTER_DRAIN) { E(acc, cur, wr, wc, fr, fq); S.done(cur); }
        if (!has_next) break;
#pragma unroll
        for (int a = 0; a < 2; ++a)
#pragma unroll
            for (int b = 0; b < 2; ++b)
#pragma unroll
                for (int m = 0; m < 4; ++m)
#pragma unroll
                    for (int n = 0; n < 2; ++n) acc[a][b][m][n] = (f32x4){0.f, 0.f, 0.f, 0.f};
        cur = nxt; cA = nA; cB = nB; ++ui;
        if constexpr (ALIGN_EPI) { if (wr == 1) PG8_BAR; }
    }
    PG8_WAIT_V(0);
    if constexpr (!ALIGN_EPI) { if (wr == 0) PG8_BAR; }
    PG8_BAR;
    if constexpr (Epi::AFTER_DRAIN) { E.fused(acc, cur, wr, wc, fr, fq, lds, wid, lane); S.done(cur); }
#undef PG8_SA
#undef PG8_SB
#undef PG8_STAGE
#undef PG8_LDA
#undef PG8_LDB
#undef PG8_MMA
#undef PG8_WAIT_V
#undef PG8_WAIT_L
#undef PG8_BAR
#undef PG8_SCHED
}
}

constexpr int NWAVES = 8, NTHR = NWAVES * 64;
constexpr int M = 65536, SEQ = 4096, D = 1024, INC = 2560, FF = 4096, NMEM = 256, MROWS = 4096  ;
constexpr float EPS = 1e-6f;
constexpr int NPHASE = 10;
#ifndef MK_N_LAUNCHES
#define MK_N_LAUNCHES 1
#endif
constexpr size_t MiB = 1u << 20;
constexpr size_t WS_RSTD0 = 1 * MiB, WS_RSTDM = 2 * MiB, WS_PWT = 3 * MiB;
constexpr size_t WS_SS1 = 768 * MiB, WS_SS2 = 772 * MiB, WS_SS3 = 776 * MiB;
constexpr size_t WS_WIN = 4 * MiB, WS_WOUT = 9 * MiB, WS_WQ = 11 * MiB, WS_WKV = 13 * MiB, WS_WO = 17 * MiB, WS_WUP = 19 * MiB, WS_WDN = 27 * MiB;
constexpr size_t WS_KB = 36 * MiB, WS_VT = 44 * MiB, WS_MEMB = 52 * MiB;
constexpr size_t WS_BUFA = 64 * MiB;
constexpr size_t WS_U = 192 * MiB;
constexpr size_t WS_LF = 512 * MiB;
constexpr size_t WS_YMIX = 640 * MiB;
constexpr size_t WS_QX = 192 * MiB, WS_OB = 320 * MiB;
constexpr size_t WS_A2 = 192 * MiB;
constexpr size_t WS_SL = 784 * MiB, WS_DL = 800 * MiB;
constexpr size_t WS_END = 801 * MiB;
constexpr int LDS_BYTES = 147456;

typedef unsigned short bf16;
typedef unsigned u32x4 __attribute__((ext_vector_type(4)));
typedef unsigned u32x2 __attribute__((ext_vector_type(2)));
typedef float f32x4 __attribute__((ext_vector_type(4)));
typedef short bf16x8 __attribute__((ext_vector_type(8)));
#define MFMA16(a, b, c) __builtin_amdgcn_mfma_f32_16x16x32_bf16((a), (b), (c), 0, 0, 0)
__device__ __forceinline__ f32x4 mfma_safe(bf16x8 a, bf16x8 b, f32x4 c) { f32x4 d = MFMA16(a, b, c); asm volatile("" : "+v"(d) : "v"(a), "v"(b)); return d; }
__device__ __forceinline__ float bflo(unsigned w) { return __uint_as_float(w << 16); }
__device__ __forceinline__ float bfhi(unsigned w) { return __uint_as_float(w & 0xffff0000u); }
__device__ __forceinline__ unsigned pk2(float lo, float hi) { return pg8::cvt_pk_bf16(lo, hi); }
__device__ __forceinline__ float wave_sum(float v) {
#pragma unroll
    for (int o = 1; o < 64; o <<= 1) v += __shfl_xor(v, o);
    return v;
}
#define LDS_FENCE() asm volatile("s_waitcnt lgkmcnt(0)" ::: "memory")
__device__ __forceinline__ f32x4 zero_acc() { f32x4 z = {0.f, 0.f, 0.f, 0.f}; asm volatile("" : "+v"(z)); return z; }

__device__ __forceinline__ void p0_transpose_item(const float* W, int K, int N, const float* gain, bf16* WT, float* scr, int item, int lane) {
    const int nblk = N / 32, kb = item / nblk, nb = item % nblk, k0 = 64 * kb, n0 = 32 * nb;
#pragma unroll 8
    for (int i = 0; i < 32; ++i) { const int kk = 2 * i + (lane >> 5); const float g = gain ? gain[k0 + kk] : 1.0f; scr[kk * 33 + (lane & 31)] = W[(size_t)(k0 + kk) * N + n0 + (lane & 31)] * g; }
    LDS_FENCE();
    const int c = lane & 7;
#pragma unroll
    for (int j = 0; j < 4; ++j) { const int n = (lane >> 3) + 8 * j; const float* s = scr + (8 * c) * 33 + n;
        u32x4 o; o.x = pk2(s[0 * 33], s[1 * 33]); o.y = pk2(s[2 * 33], s[3 * 33]); o.z = pk2(s[4 * 33], s[5 * 33]); o.w = pk2(s[6 * 33], s[7 * 33]);
        *(u32x4*)(WT + (size_t)(n0 + n) * K + k0 + 8 * c) = o; }
    LDS_FENCE();
}
__device__ __forceinline__ void p0_row(const float* xrow, bf16* orow, float* rstd_out, int lane) {
    const f32x4* xr = (const f32x4*)xrow + lane;
    f32x4 v[4]; float s = 0.f;
#pragma unroll
    for (int j = 0; j < 4; ++j) { v[j] = xr[64 * j]; s += (v[j][0] * v[j][0] + v[j][1] * v[j][1]) + (v[j][2] * v[j][2] + v[j][3] * v[j][3]); }
    s = wave_sum(s);
    u32x2* o8 = (u32x2*)orow + lane;
#pragma unroll
    for (int j = 0; j < 4; ++j) { u32x2 w; w.x = pk2(v[j][0], v[j][1]); w.y = pk2(v[j][2], v[j][3]); o8[64 * j] = w; }
    if (lane == 0) *rstd_out = rsqrtf(s * (1.0f / D) + EPS);
}

template <int G> __device__ __forceinline__ void pool_wave_unit(int tb, const bf16* U, bf16* Y, int lane) {
    constexpr int W = 2 << G;
    const int fr = lane & 15, fq = lane >> 4;
    const int row = tb * 16 + fr, t = row & (SEQ - 1);
    const int nwin = (t + 1 < W) ? (t + 1) : W; const float inv = 1.0f / (float)nwin;
    bf16x8 pf[4];
#pragma unroll
    for (int ks = 0; ks < 4; ++ks) {
        const bf16* p = U + (size_t)row * 512 + G * 128 + ks * 32 + 8 * fq;
        float a[8];
#pragma unroll
        for (int j = 0; j < 8; ++j) a[j] = 0.f;
        u32x4 cur = *(const u32x4*)p;
#pragma unroll
        for (int s = 0; s < W; ++s) { u32x4 v = *(const u32x4*)(p - (size_t)((s < nwin) ? s : 0) * 512);
            if (s >= nwin) v = (u32x4){0u, 0u, 0u, 0u};
#pragma unroll
            for (int e = 0; e < 4; ++e) { a[2 * e] += bflo(v[e]); a[2 * e + 1] += bfhi(v[e]); } }
        u32x4 o;
#pragma unroll
        for (int e = 0; e < 4; ++e) o[e] = pk2(a[2 * e] * inv - bflo(cur[e]), a[2 * e + 1] * inv - bfhi(cur[e]));
        pf[ks] = __builtin_bit_cast(bf16x8, o);
    }
#pragma unroll
    for (int ks = 0; ks < 4; ++ks) *(bf16x8*)(Y + (size_t)row * D + G * 128 + ks * 32 + 8 * fq) = pf[ks];
}

constexpr int H_QR = 0, H_KR = 17408, H_QG = 34816, H_KET = 52224, H_VT = 70656, H_P = 89088, H_O = 98304, H_WT = 132096, H_DEC = 136192;
static_assert(H_DEC + 512 <= LDS_BYTES, "hgrn LDS map");
template <bool STATE_ONLY>
__device__ __forceinline__ void hgrn_unit(unsigned char* lds, int b, int h, int seg, const bf16* U, const float* LF, const float* gnorm, bf16* Y, float* SL, float* DL) {
#define HG_BAR() do { asm volatile("s_waitcnt lgkmcnt(0)" ::: "memory"); __builtin_amdgcn_s_barrier(); asm volatile("" ::: "memory"); } while (0)
    const int tid = threadIdx.x, lane = tid & 63, w = tid >> 6, fr = lane & 15, fq = lane >> 4;
    const int dkg = tid & 15, tp = tid >> 4, dk0 = 8 * dkg, t0 = 2 * tp;
    bf16* Qr = (bf16*)(lds + H_QR); bf16* Kr = (bf16*)(lds + H_KR); bf16* Qg = (bf16*)(lds + H_QG); bf16* KeT = (bf16*)(lds + H_KET); bf16* Vt = (bf16*)(lds + H_VT); bf16* P = (bf16*)(lds + H_P);
    float* O = (float*)(lds + H_O); float* WT = (float*)(lds + H_WT); float* DEC = (float*)(lds + H_DEC);
    f32x4 S[8];
#pragma unroll
    for (int i = 0; i < 8; ++i) S[i] = (f32x4){0.f, 0.f, 0.f, 0.f};
    const int bh = b * 4 + h, c0 = seg * 16, c1 = c0 + 16;
    if constexpr (!STATE_ONLY) {
        for (int js = 0; js < seg; ++js)
#pragma unroll
            for (int i = 0; i < 8; ++i) { const f32x4 dl = *(const f32x4*)(DL + (size_t)(bh * 4 + js) * 128 + 16 * i + 4 * fq); const f32x4 sl = *(const f32x4*)(SL + ((size_t)((bh * 4 + js) * 8 + i) * NTHR + tid) * 4);
                S[i] = S[i] * (f32x4){__expf(dl[0]), __expf(dl[1]), __expf(dl[2]), __expf(dl[3])} + sl; }
    }
    float gsum[8];
#pragma unroll
    for (int j = 0; j < 8; ++j) gsum[j] = 0.f;
    constexpr size_t HSTR = (size_t)64 * 4096 * 128;
    u32x4 rq[2], rk[2], rv[2], rg[2]; f32x4 rl[2][2];
#define HG_LOAD(c) do { _Pragma("unroll") for (int tt = 0; tt < 2; ++tt) { const size_t o_ = ((size_t)bh * SEQ + (size_t)(c) * 64 + t0 + tt) * 128 + dk0; \
        if (!STATE_ONLY) rq[tt] = *(const u32x4*)(U + o_); rk[tt] = *(const u32x4*)(U + HSTR + o_); rv[tt] = *(const u32x4*)(U + 2 * HSTR + o_); \
        const float* lp = LF + o_; rl[tt][0] = *(const f32x4*)lp; rl[tt][1] = *(const f32x4*)(lp + 4); } } while (0)
#define HG_LOADG(c) do { _Pragma("unroll") for (int tt = 0; tt < 2; ++tt) { const size_t o_ = ((size_t)bh * SEQ + (size_t)(c) * 64 + t0 + tt) * 128 + dk0; rg[tt] = *(const u32x4*)(U + 3 * HSTR + o_); } } while (0)
    HG_LOAD(c0);
    for (int c = c0; c < c1; ++c) {
        float a[8], bs[8];
#pragma unroll
        for (int j = 0; j < 8; ++j) { a[j] = rl[0][j >> 2][j & 3]; bs[j] = a[j] + rl[1][j >> 2][j & 3]; }
        float x[8];
#pragma unroll
        for (int j = 0; j < 8; ++j) { x[j] = bs[j]; float y = __shfl_up(x[j], 16); if (lane >= 16) x[j] += y; y = __shfl_up(x[j], 32); if (lane >= 32) x[j] += y; }
        if (lane >= 48) { *(f32x4*)(WT + w * 128 + dk0) = (f32x4){x[0], x[1], x[2], x[3]}; *(f32x4*)(WT + w * 128 + dk0 + 4) = (f32x4){x[4], x[5], x[6], x[7]}; }
        HG_BAR();
        float base[8], gmid[8], glast[8];
#pragma unroll
        for (int j = 0; j < 8; ++j) { base[j] = 0.f; gmid[j] = 0.f; glast[j] = 0.f; }
#pragma unroll
        for (int w2 = 0; w2 < 8; ++w2) { const f32x4 v0 = *(const f32x4*)(WT + w2 * 128 + dk0), v1 = *(const f32x4*)(WT + w2 * 128 + dk0 + 4);
#pragma unroll
            for (int j = 0; j < 8; ++j) { const float tv = (j < 4) ? v0[j & 3] : v1[j & 3]; if (w2 < w) base[j] += tv; if (w2 < 4) gmid[j] += tv; glast[j] += tv; } }
        float ke[2][8];
        {
            float emid[8], elm[8];
#pragma unroll
            for (int j = 0; j < 8; ++j) { emid[j] = __expf(gmid[j]); elm[j] = __expf(glast[j] - gmid[j]); base[j] += x[j] - bs[j]; if (STATE_ONLY) gsum[j] += glast[j]; }
            if (tp == 0) { *(f32x4*)(DEC + dk0) = (f32x4){emid[0] * elm[0], emid[1] * elm[1], emid[2] * elm[2], emid[3] * elm[3]}; *(f32x4*)(DEC + dk0 + 4) = (f32x4){emid[4] * elm[4], emid[5] * elm[5], emid[6] * elm[6], emid[7] * elm[7]}; }
#pragma unroll
            for (int tt = 0; tt < 2; ++tt) { float qr[8], kr[8], qg[8];
#pragma unroll
                for (int j = 0; j < 8; ++j) { const float Gv = base[j] + (tt ? bs[j] : a[j]);
                    const float e1 = __expf(Gv - gmid[j]), e2 = __builtin_amdgcn_rcpf(e1);
                    const unsigned qw = STATE_ONLY ? 0u : rq[tt][j >> 1], kw = rk[tt][j >> 1];
                    const float q = (j & 1) ? bfhi(qw) : bflo(qw), k = (j & 1) ? bfhi(kw) : bflo(kw);
                    qr[j] = q * e1; kr[j] = k * e2; ke[tt][j] = kr[j] * elm[j]; qg[j] = qr[j] * emid[j]; }
                if constexpr (!STATE_ONLY) { const int t = t0 + tt;
                *(u32x4*)(Qr + t * 136 + dk0) = (u32x4){pk2(qr[0], qr[1]), pk2(qr[2], qr[3]), pk2(qr[4], qr[5]), pk2(qr[6], qr[7])};
                *(u32x4*)(Kr + t * 136 + dk0) = (u32x4){pk2(kr[0], kr[1]), pk2(kr[2], kr[3]), pk2(kr[4], kr[5]), pk2(kr[6], kr[7])};
                *(u32x4*)(Qg + t * 136 + dk0) = (u32x4){pk2(qg[0], qg[1]), pk2(qg[2], qg[3]), pk2(qg[4], qg[5]), pk2(qg[6], qg[7])}; }
                __builtin_amdgcn_sched_barrier(0); }
        }
#pragma unroll
        for (int j = 0; j < 8; ++j) { const int tsw = ((((t0 >> 3) ^ (dkg & 7)) << 3) | (t0 & 7));
            *(unsigned*)(KeT + (dk0 + j) * 72 + tsw) = pk2(ke[0][j], ke[1][j]);
            const unsigned v0 = rv[0][j >> 1], v1 = rv[1][j >> 1];
            *(unsigned*)(Vt + (dk0 + j) * 72 + tsw) = (j & 1) ? ((v0 >> 16) | (v1 & 0xffff0000u)) : ((v0 & 0xffffu) | (v1 << 16)); }
        HG_BAR();
        if constexpr (!STATE_ONLY) HG_LOADG(c);
        if (c + 1 < c1) HG_LOAD(c + 1);
        if constexpr (!STATE_ONLY) { const int ti = w >> 1;
#pragma unroll
          for (int s2 = 0; s2 < 2; ++s2) { const int si = 2 * (w & 1) + s2; u32x2 pw; pw.x = 0u; pw.y = 0u;
              if (si <= ti) { f32x4 sc = zero_acc();
#pragma unroll
                  for (int ks = 0; ks < 4; ++ks) { const bf16x8 kf = *(const bf16x8*)(Kr + (si * 16 + fr) * 136 + ks * 32 + 8 * fq), qf = *(const bf16x8*)(Qr + (ti * 16 + fr) * 136 + ks * 32 + 8 * fq); sc = mfma_safe(kf, qf, sc); }
                  const int tix = ti * 16 + fr, six = si * 16 + 4 * fq;
#pragma unroll
                  for (int i = 0; i < 4; ++i) if (six + i > tix) sc[i] = 0.f;
                  pw.x = pk2(sc[0], sc[1]); pw.y = pk2(sc[2], sc[3]); }
              *(u32x2*)(P + (ti * 16 + fr) * 72 + si * 16 + 4 * fq) = pw; } }
        f32x4 ao[4];
        if constexpr (!STATE_ONLY) { bf16x8 Sb[4];
#pragma unroll
          for (int kk = 0; kk < 4; ++kk) { u32x4 o; o.x = pk2(S[2 * kk][0], S[2 * kk][1]); o.y = pk2(S[2 * kk][2], S[2 * kk][3]); o.z = pk2(S[2 * kk + 1][0], S[2 * kk + 1][1]); o.w = pk2(S[2 * kk + 1][2], S[2 * kk + 1][3]); Sb[kk] = __builtin_bit_cast(bf16x8, o); }
#pragma unroll
          for (int tt = 0; tt < 4; ++tt) { ao[tt] = zero_acc();
#pragma unroll
              for (int kk = 0; kk < 4; ++kk) { const bf16* qp = Qg + (tt * 16 + fr) * 136 + 32 * kk + 4 * fq; const u32x2 lo = *(const u32x2*)qp, hi = *(const u32x2*)(qp + 16);
                  const u32x4 af = {lo.x, lo.y, hi.x, hi.y}; ao[tt] = mfma_safe(__builtin_bit_cast(bf16x8, af), Sb[kk], ao[tt]); } } }
        bf16x8 Vf[2];
#pragma unroll
        for (int ks = 0; ks < 2; ++ks) Vf[ks] = *(const bf16x8*)(Vt + (16 * w + fr) * 72 + (((ks * 4 + fq) ^ ((2 * w + (fr >> 3)) & 7)) << 3));
#pragma unroll
        for (int i = 0; i < 8; ++i) { const f32x4 dc = *(const f32x4*)(DEC + 16 * i + 4 * fq); S[i] = S[i] * dc;
#pragma unroll
            for (int ks = 0; ks < 2; ++ks) { const bf16x8 kf = *(const bf16x8*)(KeT + (16 * i + fr) * 72 + (((ks * 4 + fq) ^ ((2 * i + (fr >> 3)) & 7)) << 3)); S[i] = mfma_safe(kf, Vf[ks], S[i]); } }
        if constexpr (!STATE_ONLY) {
        HG_BAR();
#pragma unroll
        for (int tt = 0; tt < 4; ++tt)
#pragma unroll
            for (int ks = 0; ks < 2; ++ks) { const bf16x8 pf = *(const bf16x8*)(P + (tt * 16 + fr) * 72 + ks * 32 + 8 * fq); ao[tt] = mfma_safe(pf, Vf[ks], ao[tt]); }
#pragma unroll
        for (int tt = 0; tt < 4; ++tt)
#pragma unroll
            for (int i = 0; i < 4; ++i) O[(tt * 16 + 4 * fq + i) * 132 + 16 * w + fr] = ao[tt][i];
        HG_BAR();
        f32x4 gn[2]; gn[0] = *(const f32x4*)(gnorm + h * 128 + dk0); gn[1] = *(const f32x4*)(gnorm + h * 128 + dk0 + 4);
#pragma unroll
        for (int tt = 0; tt < 2; ++tt) { const int t = t0 + tt; const f32x4 o0 = *(const f32x4*)(O + t * 132 + dk0), o1 = *(const f32x4*)(O + t * 132 + dk0 + 4);
            float ssq = (o0[0] * o0[0] + o0[1] * o0[1]) + (o0[2] * o0[2] + o0[3] * o0[3]) + (o1[0] * o1[0] + o1[1] * o1[1]) + (o1[2] * o1[2] + o1[3] * o1[3]);
            ssq += __shfl_xor(ssq, 1); ssq += __shfl_xor(ssq, 2); ssq += __shfl_xor(ssq, 4); ssq += __shfl_xor(ssq, 8);
            const float rs = rsqrtf(ssq * (1.0f / 128.0f) + EPS);
            u32x4 ow;
#pragma unroll
            for (int e = 0; e < 4; ++e) { const unsigned gw = rg[tt][e]; const float oa = (e < 2) ? o0[2 * e] : o1[2 * e - 4], ob = (e < 2) ? o0[2 * e + 1] : o1[2 * e - 3];
                const float ga = (e < 2) ? gn[0][2 * e] : gn[1][2 * e - 4], gb = (e < 2) ? gn[0][2 * e + 1] : gn[1][2 * e - 3];
                ow[e] = pk2(oa * rs * ga * bflo(gw), ob * rs * gb * bfhi(gw)); }
            *(u32x4*)(Y + ((size_t)b * SEQ + (size_t)c * 64 + t) * D + 512 + h * 128 + dk0) = ow; }
        }
    }
    if constexpr (STATE_ONLY) {
#pragma unroll
        for (int i = 0; i < 8; ++i) *(f32x4*)(SL + ((size_t)((bh * 4 + seg) * 8 + i) * NTHR + tid) * 4) = S[i];
        if (tp == 0) { *(f32x4*)(DL + (size_t)(bh * 4 + seg) * 128 + dk0) = (f32x4){gsum[0], gsum[1], gsum[2], gsum[3]}; *(f32x4*)(DL + (size_t)(bh * 4 + seg) * 128 + dk0 + 4) = (f32x4){gsum[4], gsum[5], gsum[6], gsum[7]}; }
    }
#undef HG_LOAD
#undef HG_LOADG
#undef HG_BAR
}

constexpr int AT_QS = 0, AT_PS = 67584, AT_MX = 135168, AT_LS = AT_MX + 4096;
static_assert(AT_LS + 4096 <= LDS_BYTES - 16, "attention LDS map");
__device__ __forceinline__ void attn_wg(unsigned char* lds, int bx, const bf16* Q, const bf16* Kb, const bf16* Vt, bf16* Ob) {
    const int tid = threadIdx.x, lane = tid & 63, w = tid >> 6, fr = lane & 15, fq = lane >> 4;
    const int bh = bx >> 2, b = bh >> 2, h = bh & 3;
    const size_t rowbase = (size_t)b * SEQ + (size_t)(bx & 3) * 1024;
    unsigned char* Qs = lds + AT_QS; unsigned char* Ps = lds + AT_PS; float* MX = (float*)(lds + AT_MX); float* LS = (float*)(lds + AT_LS);
#define AT_BAR() do { asm volatile("s_waitcnt lgkmcnt(0)" ::: "memory"); __builtin_amdgcn_s_barrier(); asm volatile("" ::: "memory"); } while (0)
    bf16x8 Kf[2][8], Vf[2][8];
#pragma unroll
    for (int t = 0; t < 2; ++t)
#pragma unroll
        for (int ks = 0; ks < 8; ++ks) { Kf[t][ks] = *(const bf16x8*)(Kb + (size_t)(b * NMEM + 32 * w + 16 * t + fr) * D + h * 256 + ks * 32 + 8 * fq);
                                         Vf[t][ks] = *(const bf16x8*)(Vt + (size_t)(h * 256 + 32 * w + 16 * t + fr) * MROWS + b * NMEM + ks * 32 + 8 * fq); }
    u32x4 qs[4];
#define AT_QLOAD(uu) do { const char* qb_ = (const char*)(Q + (rowbase + (size_t)(uu) * 64) * D + h * 256); unsigned qoff = (unsigned)(((tid >> 5) * D + (tid & 31) * 8) * 2); \
        _Pragma("unroll") for (int i = 0; i < 4; ++i) { qs[i] = *(const u32x4*)(qb_ + qoff); qoff += 16 * D * 2; asm volatile("" : "+v"(qoff)); } } while (0)
#define AT_QSTORE() do { _Pragma("unroll") for (int i = 0; i < 4; ++i) { const int p_ = tid + NTHR * i; *(u32x4*)(Qs + (p_ >> 5) * 528 + (p_ & 31) * 16) = qs[i]; } } while (0)
    AT_QLOAD(0); AT_QSTORE(); AT_BAR();
    for (int u = 0; u < 16; ++u) {
        const size_t row0 = rowbase + (size_t)u * 64;
        char* ob_u = (char*)(Ob + row0 * D + h * 256);
        AT_QLOAD(u + 1);
        f32x4 S[2][4];
#pragma unroll
        for (int t = 0; t < 2; ++t)
#pragma unroll
            for (int rt = 0; rt < 4; ++rt) S[t][rt] = zero_acc();
#pragma unroll
        for (int rt = 0; rt < 4; ++rt)
#pragma unroll
            for (int k0 = 0; k0 < 8; k0 += 4) { bf16x8 qf[4];
#pragma unroll
                for (int k = 0; k < 4; ++k) qf[k] = *(const bf16x8*)(Qs + (rt * 16 + fr) * 528 + ((k0 + k) * 32 + 8 * fq) * 2);
                __builtin_amdgcn_sched_barrier(0);
#pragma unroll
                for (int k = 0; k < 4; ++k) { S[0][rt] = MFMA16(Kf[0][k0 + k], qf[k], S[0][rt]); S[1][rt] = MFMA16(Kf[1][k0 + k], qf[k], S[1][rt]); }
                __builtin_amdgcn_sched_barrier(0); }
#pragma unroll
        for (int rt = 0; rt < 4; ++rt) { float m = fmaxf(fmaxf(fmaxf(S[0][rt][0], S[0][rt][1]), fmaxf(S[0][rt][2], S[0][rt][3])), fmaxf(fmaxf(S[1][rt][0], S[1][rt][1]), fmaxf(S[1][rt][2], S[1][rt][3])));
            m = fmaxf(m, __shfl_xor(m, 16)); m = fmaxf(m, __shfl_xor(m, 32));
            if (fq == 0) MX[w * 64 + rt * 16 + fr] = m;
            __builtin_amdgcn_sched_barrier(0); }
        AT_BAR();
#pragma unroll
        for (int rt = 0; rt < 4; ++rt) { float gm = MX[rt * 16 + fr];
#pragma unroll
            for (int w2 = 1; w2 < 8; ++w2) gm = fmaxf(gm, MX[w2 * 64 + rt * 16 + fr]);
            float l = 0.f;
#pragma unroll
            for (int t = 0; t < 2; ++t) {
#pragma unroll
                for (int i = 0; i < 4; ++i) { const float p = __builtin_amdgcn_exp2f(S[t][rt][i] - gm); S[t][rt][i] = p; l += p; }
                u32x2 o; o.x = pk2(S[t][rt][0], S[t][rt][1]); o.y = pk2(S[t][rt][2], S[t][rt][3]);
                *(u32x2*)(Ps + (rt * 16 + fr) * 528 + (32 * w + 16 * t + 4 * fq) * 2) = o; }
            l += __shfl_xor(l, 16); l += __shfl_xor(l, 32);
            if (fq == 0) LS[w * 64 + rt * 16 + fr] = l;
            __builtin_amdgcn_sched_barrier(0); }
        AT_BAR();
        AT_QSTORE();
        f32x4 Oa[2][4];
#pragma unroll
        for (int t = 0; t < 2; ++t)
#pragma unroll
            for (int rt = 0; rt < 4; ++rt) Oa[t][rt] = zero_acc();
#pragma unroll
        for (int rt = 0; rt < 4; ++rt)
#pragma unroll
            for (int k0 = 0; k0 < 8; k0 += 4) { bf16x8 pf[4];
#pragma unroll
                for (int k = 0; k < 4; ++k) pf[k] = *(const bf16x8*)(Ps + (rt * 16 + fr) * 528 + ((k0 + k) * 32 + 8 * fq) * 2);
                __builtin_amdgcn_sched_barrier(0);
#pragma unroll
                for (int k = 0; k < 4; ++k) { Oa[0][rt] = MFMA16(Vf[0][k0 + k], pf[k], Oa[0][rt]); Oa[1][rt] = MFMA16(Vf[1][k0 + k], pf[k], Oa[1][rt]); }
                __builtin_amdgcn_sched_barrier(0); }
        unsigned ooff = (unsigned)((fr * D + 32 * w + 4 * fq) * 2);
#pragma unroll
        for (int rt = 0; rt < 4; ++rt) { float l = LS[rt * 16 + fr];
#pragma unroll
            for (int w2 = 1; w2 < 8; ++w2) l += LS[w2 * 64 + rt * 16 + fr];
            const float inv = 1.0f / l;
#pragma unroll
            for (int t = 0; t < 2; ++t) { u32x2 o; o.x = pk2(Oa[t][rt][0] * inv, Oa[t][rt][1] * inv); o.y = pk2(Oa[t][rt][2] * inv, Oa[t][rt][3] * inv);
                *(u32x2*)(ob_u + ooff + t * 32) = o; }
            ooff += 16 * D * 2; asm volatile("" : "+v"(ooff));
            __builtin_amdgcn_sched_barrier(0); }
        AT_BAR();
    }
#undef AT_BAR
#undef AT_QLOAD
#undef AT_QSTORE
}

#define LAS __attribute__((address_space(3)))
#define XB_TMO      128
#define XB_XCNT(j)  (256  + 64 * (j))
#define XB_XSUB(j)  (1280 + 64 * (j))
#define XB_XGEN(j)  (2304 + 64 * (j))
#define XB_TOP      3328
#define XB_TOPGEN   3392
#define XCD_BAR_WORDS 3456
#define XB_SPIN_CAP (1u << 18)

__device__ __forceinline__ unsigned xb_ld(unsigned* p)              { return __hip_atomic_load(p, __ATOMIC_RELAXED, __HIP_MEMORY_SCOPE_AGENT); }
__device__ __forceinline__ unsigned xb_add(unsigned* p, unsigned v) { return __hip_atomic_fetch_add(p, v, __ATOMIC_RELAXED, __HIP_MEMORY_SCOPE_AGENT); }
__device__ __forceinline__ unsigned xb_xcc_id() { return (unsigned)__builtin_amdgcn_s_getreg((3 << 11) | 20) & 0xFu; }
#define XB_SPIN(cond, bar) do { unsigned _sp = 0; while (cond) { __builtin_amdgcn_s_sleep(1); \
    if ((++_sp & 255u) == 0u) { if (xb_ld(&(bar)[XB_TMO])) break; if (_sp > XB_SPIN_CAP) { atomicAdd(&(bar)[XB_TMO], 1u); break; } } } } while (0)

struct XcdBarrier {
    unsigned* bar; unsigned x;
    volatile LAS unsigned* st;
};

__device__ __forceinline__ XcdBarrier xcd_barrier_post(unsigned* bar, volatile LAS unsigned* st) {
    XcdBarrier b; b.bar = bar; b.x = xb_xcc_id(); b.st = st;
    if (threadIdx.x == 0) (void)xb_add(&bar[XB_XCNT(b.x)], 1u);
    return b;
}
__device__ __forceinline__ void xcd_barrier_complete(unsigned* bar, unsigned x, unsigned& nloc, unsigned& nx) {
    const unsigned G = gridDim.x * gridDim.y * gridDim.z;
    unsigned sum, cnt, mine, sp = 0u;
    for (;;) {
        sum = 0u; cnt = 0u; mine = 0u;
#pragma unroll
        for (unsigned j = 0; j < 16; ++j) { const unsigned c = xb_ld(&bar[XB_XCNT(j)]); sum += c; cnt += (c > 0u) ? 1u : 0u; mine = (j == x) ? c : mine; }
        if (sum == G) break;
        __builtin_amdgcn_s_sleep(1);
        if ((++sp & 255u) == 0u) { if (xb_ld(&bar[XB_TMO])) break; if (sp > XB_SPIN_CAP) { atomicAdd(&bar[XB_TMO], 1u); break; } }
    }
    nloc = mine > 0u ? mine : 1u; nx = cnt > 0u ? cnt : 1u;
}

__device__ __forceinline__ void xcd_barrier(const XcdBarrier& b) {
    asm volatile("s_waitcnt vmcnt(0)" ::: "memory");
    __syncthreads();
    if (threadIdx.x == 0) {
        unsigned* bar = b.bar;
        __builtin_amdgcn_s_waitcnt(0);
        unsigned nloc = b.st[0], nx = b.st[1];
        if (nloc == 0u) { xcd_barrier_complete(bar, b.x, nloc, nx); b.st[0] = nloc; b.st[1] = nx; }
        const unsigned old = xb_add(&bar[XB_XSUB(b.x)], 1u);
        const unsigned gen = old / nloc;
        if (old + 1u == (gen + 1u) * nloc) {
            __builtin_amdgcn_fence(__ATOMIC_RELEASE, "agent");
            asm volatile("s_waitcnt vmcnt(0)" ::: "memory");
            const unsigned og = xb_add(&bar[XB_TOP], 1u);
            const unsigned tg = og / nx;
            if (og + 1u == (tg + 1u) * nx) xb_add(&bar[XB_TOPGEN], 1u);
            else XB_SPIN(xb_ld(&bar[XB_TOPGEN]) == tg, bar);
            __builtin_amdgcn_fence(__ATOMIC_ACQUIRE, "agent");
            xb_add(&bar[XB_XGEN(b.x)], 1u);
            asm volatile("s_waitcnt vmcnt(0)" ::: "memory");
        } else {
            XB_SPIN(xb_ld(&bar[XB_XGEN(b.x)]) == gen, bar);
            __builtin_amdgcn_fence(__ATOMIC_ACQUIRE, "agent");
            asm volatile("s_waitcnt vmcnt(0)" ::: "memory");
        }
    }
    __syncthreads();
}

struct Args { const float* in[18]; float* out; unsigned char* ws; int ph_lo, ph_hi; };
__global__ void __launch_bounds__(NTHR, 2) mk_fwd(Args args) {
    extern __shared__ __attribute__((aligned(16))) unsigned char lds[];
    cg::grid_group grid = cg::this_grid();
    PG8_LAS unsigned char* lds3 = (PG8_LAS unsigned char*)lds;
    const int tid = threadIdx.x, lane = tid & 63, wave = __builtin_amdgcn_readfirstlane(tid >> 6);
    const int G = gridDim.x, bx = blockIdx.x;
    unsigned char* ws = args.ws;
    const float* x = args.in[0]; float* out = args.out;
    float* rstd0 = (float*)(ws + WS_RSTD0); float* ss1 = (float*)(ws + WS_SS1); float* ss2 = (float*)(ws + WS_SS2); float* ss3 = (float*)(ws + WS_SS3); float* rstdm = (float*)(ws + WS_RSTDM);
    bf16* PWt = (bf16*)(ws + WS_PWT);
    bf16* Win_t = (bf16*)(ws + WS_WIN); bf16* Wout_t = (bf16*)(ws + WS_WOUT); bf16* Wq_t = (bf16*)(ws + WS_WQ); bf16* Wkv_t = (bf16*)(ws + WS_WKV); bf16* Wo_t = (bf16*)(ws + WS_WO); bf16* Wup_t = (bf16*)(ws + WS_WUP); bf16* Wdn_t = (bf16*)(ws + WS_WDN);
    bf16* Kb = (bf16*)(ws + WS_KB); bf16* Vtg = (bf16*)(ws + WS_VT); bf16* memb = (bf16*)(ws + WS_MEMB);
    bf16* bufA = (bf16*)(ws + WS_BUFA); bf16* Ub = (bf16*)(ws + WS_U); bf16* Hb = (bf16*)(ws + WS_U + 64 * MiB); float* LFb = (float*)(ws + WS_LF); bf16* Ymix = (bf16*)(ws + WS_YMIX);
    bf16* Qx = (bf16*)(ws + WS_QX); bf16* Obuf = (bf16*)(ws + WS_OB); bf16* A2 = (bf16*)(ws + WS_A2);
    const int lo = args.ph_lo, hi = args.ph_hi;
    volatile LAS unsigned* bst = (volatile LAS unsigned*)(lds3 + (LDS_BYTES - 16));
    if (tid < 2) bst[tid] = 0u;
    __syncthreads();
    XcdBarrier xbar; xbar.bar = (unsigned*)ws; xbar.x = xb_xcc_id(); xbar.st = bst;
    if (bx == 0) for (int i = tid; i < XCD_BAR_WORDS; i += NTHR) ((unsigned*)ws)[i] = 0u;
#ifdef DBG_STOP
#define PH_MASK ((2 << DBG_STOP) - 1)
#endif
#ifndef PH_MASK
#define PH_MASK 0x3ff
#endif
#define IN(k) (((PH_MASK >> (k)) & 1) && lo <= (k) && (k) < hi)
#define SEAM(k) do { if (lo <= (k) && (k) + 1 < hi) { if ((k) != 0) { xcd_barrier(xbar); } else { asm volatile("s_waitcnt vmcnt(0) lgkmcnt(0)" ::: "memory"); grid.sync(); __builtin_amdgcn_fence(__ATOMIC_ACQUIRE, "agent"); asm volatile("s_waitcnt vmcnt(0)" ::: "memory"); __builtin_amdgcn_s_barrier(); asm volatile("" ::: "memory"); } } } while (0)

    if (IN(0)) {
        float* scr = (float*)(lds + wave * 16384);
        const int gw = bx * NWAVES + wave, NGW = G * NWAVES;
        constexpr int I_IN = (D / 64) * (INC / 32), I_SQ = (D / 64) * (D / 32), I_KV = (D / 64) * (2 * D / 32), I_UP = (D / 64) * (FF / 32), I_DN = (FF / 64) * (D / 32);
        constexpr int NITEMS = I_IN + 3 * I_SQ + I_KV + I_UP + I_DN;
        for (int it = gw; it < NITEMS; it += NGW) {
            int r = it;
            if (r < I_IN) { if (r % (INC / 32) >= 16) p0_transpose_item(args.in[3], D, INC, args.in[2], Win_t, scr, r, lane); continue; } r -= I_IN;
            if (r < I_SQ) { p0_transpose_item(args.in[8], D, D, nullptr, Wout_t, scr, r, lane); continue; } r -= I_SQ;
            if (r < I_SQ) { p0_transpose_item(args.in[11], D, D, args.in[9], Wq_t, scr, r, lane); continue; } r -= I_SQ;
            if (r < I_KV) { p0_transpose_item(args.in[12], D, 2 * D, args.in[10], Wkv_t, scr, r, lane); continue; } r -= I_KV;
            if (r < I_SQ) { p0_transpose_item(args.in[13], D, D, nullptr, Wo_t, scr, r, lane); continue; } r -= I_SQ;
            if (r < I_UP) { p0_transpose_item(args.in[15], D, FF, args.in[14], Wup_t, scr, r, lane); continue; } r -= I_UP;
            p0_transpose_item(args.in[16], FF, D, nullptr, Wdn_t, scr, r, lane);
        }
        for (int m = gw; m < M; m += NGW) p0_row(x + (size_t)m * D, bufA + (size_t)m * D, rstd0 + m, lane);
        for (int m = gw; m < MROWS; m += NGW) p0_row(args.in[1] + (size_t)m * D, memb + (size_t)m * D, rstdm + m, lane);
        const int gt = bx * NTHR + tid, NGT = G * NTHR;
        (void)gt; (void)NGT;
        __syncthreads();
        { float* Af = (float*)lds; float* Pf = (float*)(lds + 16 * 129 * 4 + 64);
          for (int tile = bx; tile < 256; tile += G) { const int g = tile & 3, k0 = (tile >> 2) * 16;
              for (int i = 0; i < 4; ++i) { const int idx = tid + NTHR * i, k = idx >> 7, c = idx & 127; Af[k * 129 + c] = args.in[3][(size_t)(k0 + k) * INC + g * 128 + c] * args.in[2][k0 + k]; }
              for (int i = 0; i < 32; ++i) { const int idx = tid + NTHR * i; Pf[idx] = args.in[4][g * 16384 + idx]; }
              __syncthreads();
              const int d = tid & 127, kq = tid >> 7; float acc[4];
#pragma unroll
              for (int i = 0; i < 4; ++i) acc[i] = 0.f;
              for (int c = 0; c < 128; ++c) { const float p = Pf[c * 128 + d];
#pragma unroll
                  for (int i = 0; i < 4; ++i) acc[i] += Af[(kq * 4 + i) * 129 + c] * p; }
              const float sc = args.in[5][g * 128 + d];
              u32x2 o0; o0.x = pk2(acc[0] * sc, acc[1] * sc); o0.y = pk2(acc[2] * sc, acc[3] * sc);
              *(u32x2*)(Win_t + (size_t)(g * 128 + d) * D + k0 + kq * 4) = o0;
              __syncthreads(); } }
    }
    SEAM(0);
    if (tid == 0) (void)xb_add(&xbar.bar[XB_XCNT(xbar.x)], 1u);
    if (IN(1)) {
        pg8::Gemm g{bufA, Win_t, M, INC, D}; pg8::StaticOrder S; S.init(M, INC, G, bx);
        pg8::EpiU E{Ub, Hb, LFb, rstd0, args.in[6], {0.f, 0.f, 0.f, 0.f, 0.f, 0.f, 0.f, 0.f}, -1};
        pg8::gemm_phase<pg8::EpiU, pg8::StaticOrder, true, true>(lds3, g, S, E);
    }
    SEAM(1);
    if (IN(2)) {
        float* SLb = (float*)(ws + WS_SL); float* DLb = (float*)(ws + WS_DL);
        if ((bx & 3) != 3) hgrn_unit<true>(lds, bx >> 4, (bx >> 2) & 3, bx & 3, Hb, LFb, args.in[7], Ymix, SLb, DLb);
        {
            const int gw = bx * NWAVES + wave, NGW = G * NWAVES;
            for (int wu = gw; wu < (M / 16) * 4; wu += NGW) { const int g = wu & 3, tb = wu >> 2;
                if (g == 0) pool_wave_unit<0>(tb, Ub, Ymix, lane); else if (g == 1) pool_wave_unit<1>(tb, Ub, Ymix, lane); else if (g == 2) pool_wave_unit<2>(tb, Ub, Ymix, lane); else pool_wave_unit<3>(tb, Ub, Ymix, lane); }
            __syncthreads();
            if ((bx & 3) == 3) {
            const int cc = bx >> 2;
            { pg8::Gemm g{memb, Wkv_t, MROWS, D, D}; pg8::StaticOrder S; S.init(MROWS, D, G, cc);
              pg8::EpiScale<false, false, false> E{Kb, D, rstdm, 0.0625f * 1.44269504088896f};
              pg8::gemm_phase<pg8::EpiScale<false, false, false>, pg8::StaticOrder, true, true>(lds3, g, S, E); }
            { pg8::Gemm g{Wkv_t + (size_t)D * D, memb, D, MROWS, D}; pg8::StaticOrder S; S.init(D, MROWS, G, cc);
              pg8::EpiScale<true, false, false> E{Vtg, MROWS, rstdm, 1.0f};
              pg8::gemm_phase<pg8::EpiScale<true, false, false>, pg8::StaticOrder, true, true>(lds3, g, S, E); }
            }
        }
        xcd_barrier(xbar);
        hgrn_unit<false>(lds, bx >> 4, (bx >> 2) & 3, bx & 3, Hb, LFb, args.in[7], Ymix, SLb, DLb);
    }
    SEAM(2);
    if (IN(3)) {
        pg8::Gemm g{Ymix, Wout_t, M, D, D}; pg8::StaticOrder S; S.init(M, D, G, bx);
        pg8::EpiResid<false, false, true> E{x, nullptr, bufA, ss1};
        pg8::gemm_phase<pg8::EpiResid<false, false, true>, pg8::StaticOrder, true, true>(lds3, g, S, E);
    }
    SEAM(3);
    if (IN(4)) {
        pg8::Gemm g{bufA, Wq_t, M, D, D}; pg8::StaticOrder S; S.init(M, D, G, bx);
        pg8::EpiScale<false, false, true> E{Qx, D, ss1, 1.0f};
        pg8::gemm_phase<pg8::EpiScale<false, false, true>, pg8::StaticOrder, true, true>(lds3, g, S, E);
    }
    SEAM(4);
    if (IN(5)) {
        attn_wg(lds, bx, Qx, Kb, Vtg, Obuf);
    }
    SEAM(5);
    if (IN(6)) {
        pg8::Gemm g{Obuf, Wo_t, M, D, D}; pg8::StaticOrder S; S.init(M, D, G, bx);
        pg8::EpiResid<true, false, true> E{bufA, nullptr, bufA, ss2};
        pg8::gemm_phase<pg8::EpiResid<true, false, true>, pg8::StaticOrder, true, true>(lds3, g, S, E);
    }
    SEAM(6);
    if (IN(7)) {
        pg8::Gemm g{bufA, Wup_t, M, FF, D}; pg8::StaticOrder S; S.init(M, FF, G, bx);
        pg8::EpiUp E{A2, ss2, {0.f, 0.f, 0.f, 0.f, 0.f, 0.f, 0.f, 0.f}, -1};
        pg8::gemm_phase<pg8::EpiUp, pg8::StaticOrder, true, true>(lds3, g, S, E);
    }
    SEAM(7);
    if (IN(8)) {
        pg8::Gemm g{A2, Wdn_t, M, D, FF}; pg8::StaticOrder S; S.init(M, D, G, bx);
        pg8::EpiResid<true, false, true> E{bufA, nullptr, bufA, ss3};
        pg8::gemm_phase<pg8::EpiResid<true, false, true>, pg8::StaticOrder, true, true>(lds3, g, S, E);
    }
    SEAM(8);
    if (IN(9)) {
        const int gw = bx * NWAVES + wave, NGW = G * NWAVES;
        const f32x4* gf = (const f32x4*)args.in[17] + lane;
        f32x4 gv[4];
#pragma unroll
        for (int j = 0; j < 4; ++j) gv[j] = gf[64 * j];
        for (int m = gw; m < M; m += NGW) { f32x4* o = (f32x4*)(out + (size_t)m * D) + lane; const u32x2* hb = (const u32x2*)(bufA + (size_t)m * D) + lane;
            float sv = (lane < 16) ? ss3[(size_t)m * 16 + lane] : 0.f; sv += __shfl_xor(sv, 1); sv += __shfl_xor(sv, 2); sv += __shfl_xor(sv, 4); sv += __shfl_xor(sv, 8); sv = __shfl(sv, 0); const float rs = rsqrtf(sv * (1.0f / D) + EPS);
#pragma unroll
            for (int j = 0; j < 4; ++j) { const u32x2 w = hb[64 * j]; const f32x4 hv = {bflo(w.x), bfhi(w.x), bflo(w.y), bfhi(w.y)}; o[64 * j] = hv * rs * gv[j]; } }
    }
#ifdef DBG_STOP
    { asm volatile("s_waitcnt vmcnt(0) lgkmcnt(0)" ::: "memory"); grid.sync(); __builtin_amdgcn_fence(__ATOMIC_ACQUIRE, "agent"); asm volatile("s_waitcnt vmcnt(0)" ::: "memory");
      const size_t gt = (size_t)bx * NTHR + tid, NGT = (size_t)G * NTHR;
      for (size_t i = gt; i < (size_t)M * D; i += NGT) { const size_t m = i >> 10, c = i & 1023; float v = 0.f;
          if (DBG_STOP == 0) v = bflo(bufA[i]) + rstd0[m] + bflo(Win_t[i % (2560u * 1024u)]) + bflo(Wup_t[i % (4096u * 1024u)]) + bflo(Wdn_t[(i * 7) % (4096u * 1024u)]) + bflo(Wkv_t[i % (2048u * 1024u)]) + bflo(Wq_t[i % (1024u * 1024u)]) + bflo(Wo_t[i % (1024u * 1024u)]) + bflo(Wout_t[i % (1024u * 1024u)]) + bflo(memb[i % (4096u * 1024u)]) + rstdm[m & 4095];
          if (DBG_STOP == 1) v = bflo(Ub[m * 512 + (c & 511)]) + bflo(Hb[i]) + bflo(Hb[i + 67108864]) + LFb[m * 512 + (c & 511)];
          if (DBG_STOP == 2) { if (DBG_SUB == 0) v = bflo(Ymix[m * D + (c & 511)]); if (DBG_SUB == 1) v = bflo(Ymix[m * D + 512 + (c & 511)]); if (DBG_SUB == 2) v = bflo(Kb[(m & 4095) * D + c]); if (DBG_SUB == 3) v = bflo(Vtg[c * MROWS + (m & 4095)]); if (DBG_SUB == 4) v = bflo(Ymix[i]) + bflo(Kb[(m & 4095) * D + c]) + bflo(Vtg[c * MROWS + (m & 4095)]); }
          if (DBG_STOP == 3) v = out[i] + bflo(bufA[i]) + ss1[m * 16 + (c & 15)];
          if (DBG_STOP == 4) v = bflo(Qx[i]);
          if (DBG_STOP == 5) v = bflo(Obuf[i]);
          if (DBG_STOP == 6) v = out[i] + bflo(bufA[i]) + ss2[m * 16 + (c & 15)];
          if (DBG_STOP == 7) v = bflo(A2[m * FF + c]) + bflo(A2[m * FF + 1024 + c]) + bflo(A2[m * FF + 2048 + c]) + bflo(A2[m * FF + 3072 + c]);
          if (DBG_STOP == 8) v = out[i] + ss3[m * 16 + (c & 15)];
          out[i] = v; } }
#endif
#undef IN
#undef SEAM
}

extern "C" void kernel_launch(void* const* d_in, const int* in_sizes, int n_in, void* d_out, int out_size, void* d_ws, size_t ws_size, hipStream_t stream) {
    static int grid = 0;
    if (grid == 0) {
        if (n_in != 18 || in_sizes[0] != M * D || out_size != M * D || ws_size < WS_END) { fprintf(stderr, "kernel_launch: unexpected shapes (n_in %d, in0 %d, out %d, ws %zu); nothing launched\n", n_in, n_in > 0 ? in_sizes[0] : -1, out_size, ws_size); grid = -1; return; }
        int dev = 0, cus = 0, per_cu = 0;
        if (hipGetDevice(&dev) != hipSuccess || hipDeviceGetAttribute(&cus, hipDeviceAttributeMultiprocessorCount, dev) != hipSuccess) { grid = -1; return; }
        if (hipFuncSetAttribute((const void*)mk_fwd, hipFuncAttributeMaxDynamicSharedMemorySize, LDS_BYTES) != hipSuccess) { fprintf(stderr, "kernel_launch: hipFuncSetAttribute failed\n"); grid = -1; return; }
        if (hipOccupancyMaxActiveBlocksPerMultiprocessor(&per_cu, (const void*)mk_fwd, NTHR, LDS_BYTES) != hipSuccess || per_cu < 1) { fprintf(stderr, "kernel_launch: occupancy query failed (%d)\n", per_cu); (void)hipGetLastError(); grid = -1; return; }
        grid = cus * per_cu;
        if (grid > 256) grid = 256;
        if (grid != 256) { fprintf(stderr, "kernel_launch: this kernel needs exactly 256 co-resident workgroups (got %d); nothing launched\n", grid); grid = -1; return; }
    }
    if (grid < 0) return;
    Args a{};
    for (int i = 0; i < 18; ++i) a.in[i] = (const float*)d_in[i];
    a.out = (float*)d_out; a.ws = (unsigned char*)d_ws;
#if MK_N_LAUNCHES == 1
    a.ph_lo = 0; a.ph_hi = NPHASE;
    void* kargs[] = {&a};
    hipError_t e = hipLaunchCooperativeKernel((const void*)mk_fwd, dim3(grid), dim3(NTHR), kargs, LDS_BYTES, stream);
    if (e != hipSuccess) fprintf(stderr, "kernel_launch: cooperative launch failed: %s (grid %d)\n", hipGetErrorString(e), grid);
#else
    for (int p = 0; p < NPHASE; ++p) { a.ph_lo = p; a.ph_hi = p + 1; hipLaunchKernelGGL(mk_fwd, dim3(grid), dim3(NTHR), LDS_BYTES, stream, a); }
#endif
}
```

```cpp
#include <hip/hip_runtime.h>
#include <hip/hip_cooperative_groups.h>
#include <cstdio>
#include <cstdint>
namespace cg = cooperative_groups;
namespace pg8 {
#define PG8_LAS __attribute__((address_space(3)))
typedef unsigned short bf16_t;
typedef short bf16x8 __attribute__((ext_vector_type(8)));
typedef float f32x4 __attribute__((ext_vector_type(4)));
typedef unsigned u32x4 __attribute__((ext_vector_type(4)));
constexpr int BM = 256, BK = 64, HALF = 128, HTB = HALF * BK * 2  , STAGE_BYTES = 8 * HTB, NXCD = 8, WGM = 8;

__host__ __device__ __forceinline__ int lds_byte(int r, int c) { const int st = (r >> 4) * 2 + (c >> 5), rr = r & 15, cc = c & 31, ob = rr * 64 + cc * 2; return st * 1024 + (ob ^ (((ob >> 9) & 1) << 5)); }
__host__ __device__ __forceinline__ void stage_rc(int b, int& R, int& C) { const int st = b / 1024, sb = b % 1024, swz = sb ^ (((sb >> 9) & 1) << 5); R = (st >> 1) * 16 + swz / 64; C = (st & 1) * 32 + (swz % 64) / 2; }
__host__ __device__ __forceinline__ int perm32(int rho) { const int n = rho >> 4, i = rho & 15; return 8 * (i >> 2) + 4 * n + (i & 3); }

struct Unit { int pm, pn; };
struct Gemm { const bf16_t* A; const bf16_t* Bt; int M, N, K; };

struct StaticOrder {
    int nM, nN, nwg, G, c;
    __host__ __device__ void init(int M, int N, int G_, int c_) { nM = M / BM; nN = N / BM; nwg = nM * nN; G = G_; c = c_; }
    __host__ __device__ bool next(int i, Unit& u) const {
        const long L = (long)i * G + c; if (L >= nwg) return false;
        int wgid = (int)L; { const int q = nwg / NXCD, r = nwg % NXCD, xcd = wgid % NXCD, off = wgid / NXCD; wgid = (xcd < r ? xcd * (q + 1) : r * (q + 1) + (xcd - r) * q) + off; }
        const int nig = WGM * nN, gid = wgid / nig, fm = gid * WGM, gsz = (nM - fm) < WGM ? (nM - fm) : WGM;
        u.pm = fm + ((wgid % nig) % gsz); u.pn = (wgid % nig) / gsz; return true;
    }
    __device__ __forceinline__ void a_ready(const Unit&) const {}
    __device__ __forceinline__ void done(const Unit&) const {}
};

typedef float f32x2c_t __attribute__((ext_vector_type(2))); typedef __bf16 bf16x2c_t __attribute__((ext_vector_type(2)));
__device__ __forceinline__ unsigned cvt_pk_bf16(float lo, float hi) { const f32x2c_t v = {lo, hi}; const bf16x2c_t b = __builtin_convertvector(v, bf16x2c_t); return __builtin_bit_cast(unsigned, b); }
typedef float f32x2 __attribute__((ext_vector_type(2)));
__device__ __forceinline__ float sigmoid_f(float x) { return __builtin_amdgcn_rcpf(1.0f + __expf(-x)); }
__device__ __forceinline__ float silu_f(float x) { return x * sigmoid_f(x); }
__device__ __forceinline__ u32x4 pack8(const f32x4 a, const f32x4 b) { u32x4 w; w.x = cvt_pk_bf16(a[0], a[1]); w.y = cvt_pk_bf16(a[2], a[3]); w.z = cvt_pk_bf16(b[0], b[1]); w.w = cvt_pk_bf16(b[2], b[3]); return w; }

struct EpiU {
    static constexpr bool PERM = true, AFTER_DRAIN = false;
    bf16_t* UP; bf16_t* H; float* LF; const float* rstd; const float* lbt;
    __device__ __forceinline__ void operator()(const f32x4 (&acc)[2][2][4][2], const Unit& u, int wr, int wc, int fr, int fq) const {
        const int row0 = u.pm * BM + wr * 64 + fr, kind = u.pn >> 1, d0 = wc * 32 + 8 * fq;
        if (kind == 0) {
#pragma unroll
            for (int ai = 0; ai < 2; ++ai)
#pragma unroll
                for (int m = 0; m < 4; ++m) { const int row = row0 + ai * HALF + m * 16; const float rs = rstd[row];
#pragma unroll
                    for (int bj = 0; bj < 2; ++bj) *(u32x4*)(UP + (size_t)row * 512 + u.pn * BM + bj * HALF + d0) = pack8(acc[ai][bj][m][0] * rs, acc[ai][bj][m][1] * rs); }
        } else if (kind == 2) {
            f32x4 lb[2][2];
#pragma unroll
            for (int bj = 0; bj < 2; ++bj)
#pragma unroll
                for (int n = 0; n < 2; ++n) { const int c = (u.pn & 1) * BM + bj * HALF + d0 + 4 * n; const f32x4 t0 = *(const f32x4*)(lbt + c), t1 = *(const f32x4*)(lbt + 512 + c);
#pragma unroll
                    for (int e = 0; e < 4; ++e) lb[bj][n][e] = __builtin_amdgcn_rcpf(1.0f + __expf(t1[e] - t0[e])); }
#pragma unroll
            for (int ai = 0; ai < 2; ++ai)
#pragma unroll
                for (int m = 0; m < 4; ++m) { const int row = row0 + ai * HALF + m * 16; const float rs = rstd[row];
#pragma unroll
                    for (int bj = 0; bj < 2; ++bj) { f32x4 lf[2], kk[2];
#pragma unroll
                        for (int n = 0; n < 2; ++n)
#pragma unroll
                            for (int e = 0; e < 4; ++e) { const float z = acc[ai][bj][m][n][e] * rs, l = lb[bj][n][e], f = l + (1.0f - l) * sigmoid_f(z); lf[n][e] = __logf(f); kk[n][e] = 1.0f - f; }
                        const size_t hoff = ((size_t)((row >> 12) * 4 + (u.pn & 1) * 2 + bj) * 4096 + (row & 4095)) * 128 + d0;
                        float* lp = LF + hoff; *(f32x4*)lp = lf[0]; *(f32x4*)(lp + 4) = lf[1];
                        *(u32x4*)(H + (size_t)1 * 64 * 4096 * 128 + hoff) = pack8(kk[0], kk[1]); } }
        } else {
            const bool act = (kind == 1) || (kind == 4);
            bf16_t* Hk = H + (size_t)(kind - 1) * 64 * 4096 * 128;
#pragma unroll
            for (int ai = 0; ai < 2; ++ai)
#pragma unroll
                for (int m = 0; m < 4; ++m) { const int row = row0 + ai * HALF + m * 16; const float rs = rstd[row];
#pragma unroll
                    for (int bj = 0; bj < 2; ++bj) { f32x4 v0 = acc[ai][bj][m][0] * rs, v1 = acc[ai][bj][m][1] * rs;
                        if (act) {
#pragma unroll
                            for (int e = 0; e < 4; ++e) { v0[e] = silu_f(v0[e]); v1[e] = silu_f(v1[e]); } }
                        const size_t hoff = ((size_t)((row >> 12) * 4 + (u.pn & 1) * 2 + bj) * 4096 + (row & 4095)) * 128 + d0;
                        *(u32x4*)(Hk + hoff) = pack8(v0, v1); } }
        }
    }
};
template <bool COLSCALE, bool RELU2, bool FROM_SS> struct EpiScale {
    static constexpr bool PERM = true, AFTER_DRAIN = false;
    bf16_t* O; int ldc; const float* sc; float mul;
    __device__ __forceinline__ void operator()(const f32x4 (&acc)[2][2][4][2], const Unit& u, int wr, int wc, int fr, int fq) const {
        const int row0 = u.pm * BM + wr * 64 + fr, col0 = u.pn * BM + wc * 32 + 8 * fq;
        f32x4 cs[2][2];
        if (COLSCALE) {
#pragma unroll
            for (int bj = 0; bj < 2; ++bj)
#pragma unroll
                for (int n = 0; n < 2; ++n) cs[bj][n] = *(const f32x4*)(sc + col0 + bj * HALF + 4 * n) * mul;
        }
#pragma unroll
        for (int ai = 0; ai < 2; ++ai)
#pragma unroll
            for (int m = 0; m < 4; ++m) { const int row = row0 + ai * HALF + m * 16; float rs = 1.0f;
                if (!COLSCALE) { if (FROM_SS) { const f32x4* sp = (const f32x4*)(sc + (size_t)row * 16); const f32x4 p0 = sp[0], p1 = sp[1], p2 = sp[2], p3 = sp[3];
                        const float ssum = ((p0[0] + p0[1]) + (p0[2] + p0[3])) + ((p1[0] + p1[1]) + (p1[2] + p1[3])) + ((p2[0] + p2[1]) + (p2[2] + p2[3])) + ((p3[0] + p3[1]) + (p3[2] + p3[3]));
                        rs = rsqrtf(ssum * (1.0f / 1024.0f) + 1e-6f) * mul; } else rs = sc[row] * mul; }
#pragma unroll
                for (int bj = 0; bj < 2; ++bj) { f32x4 v0, v1;
                    if (COLSCALE) { v0 = acc[ai][bj][m][0] * cs[bj][0]; v1 = acc[ai][bj][m][1] * cs[bj][1]; } else { v0 = acc[ai][bj][m][0] * rs; v1 = acc[ai][bj][m][1] * rs; }
                    if (RELU2) {
#pragma unroll
                        for (int e = 0; e < 4; ++e) { const float a = fmaxf(v0[e], 0.f), b = fmaxf(v1[e], 0.f); v0[e] = a * a; v1[e] = b * b; } }
                    *(u32x4*)(O + (size_t)row * ldc + col0 + bj * HALF) = pack8(v0, v1); } }
    }
};
struct EpiUp {
    static constexpr bool PERM = true, AFTER_DRAIN = false;
    bf16_t* O; const float* sc; mutable float rsc[8]; mutable int cpm;
    __device__ __forceinline__ void operator()(const f32x4 (&acc)[2][2][4][2], const Unit& u, int wr, int wc, int fr, int fq) const {
        const int row0 = u.pm * BM + wr * 64 + fr, col0 = u.pn * BM + wc * 32 + 8 * fq;
        if (u.pm != cpm) { cpm = u.pm;
#pragma unroll
            for (int ai = 0; ai < 2; ++ai)
#pragma unroll
                for (int m = 0; m < 4; ++m) { const int row = row0 + ai * HALF + m * 16; const f32x4* sp = (const f32x4*)(sc + (size_t)row * 16); const f32x4 p0 = sp[0], p1 = sp[1], p2 = sp[2], p3 = sp[3];
                    const float ssum = ((p0[0] + p0[1]) + (p0[2] + p0[3])) + ((p1[0] + p1[1]) + (p1[2] + p1[3])) + ((p2[0] + p2[1]) + (p2[2] + p2[3])) + ((p3[0] + p3[1]) + (p3[2] + p3[3]));
                    rsc[ai * 4 + m] = rsqrtf(ssum * (1.0f / 1024.0f) + 1e-6f); } }
#pragma unroll
        for (int ai = 0; ai < 2; ++ai)
#pragma unroll
            for (int m = 0; m < 4; ++m) { const int row = row0 + ai * HALF + m * 16; const float rs = rsc[ai * 4 + m];
#pragma unroll
                for (int bj = 0; bj < 2; ++bj) { f32x4 v0 = acc[ai][bj][m][0] * rs, v1 = acc[ai][bj][m][1] * rs;
#pragma unroll
                    for (int e = 0; e < 4; ++e) { const float a = fmaxf(v0[e], 0.f), b = fmaxf(v1[e], 0.f); v0[e] = a * a; v1[e] = b * b; }
                    *(u32x4*)(O + (size_t)row * 4096 + col0 + bj * HALF) = pack8(v0, v1); } }
    }
};
struct EpiQ {
    static constexpr bool PERM = true, AFTER_DRAIN = false;
    bf16_t* O; const PG8_LAS float* tab;
    __device__ __forceinline__ void operator()(const f32x4 (&acc)[2][2][4][2], const Unit& u, int wr, int wc, int fr, int fq) const {
        const int rl0 = wr * 64 + fr, col0 = u.pn * BM + wc * 32 + 8 * fq; const PG8_LAS float* t = tab + ((u.pm >> 3) & 3) * 256;
#pragma unroll
        for (int ai = 0; ai < 2; ++ai)
#pragma unroll
            for (int m = 0; m < 4; ++m) { const int rl = rl0 + ai * HALF + m * 16; const float rs = t[rl];
#pragma unroll
                for (int bj = 0; bj < 2; ++bj) *(u32x4*)(O + (size_t)(u.pm * BM + rl) * 1024 + col0 + bj * HALF) = pack8(acc[ai][bj][m][0] * rs, acc[ai][bj][m][1] * rs); }
    }
};
template <bool BASE_BF16, bool WRITE_F32, bool WRITE_B> struct EpiResid {
    static constexpr bool PERM = true, AFTER_DRAIN = false;
    const void* base; float* out; bf16_t* ob; float* ss;
    __device__ __forceinline__ void operator()(const f32x4 (&acc)[2][2][4][2], const Unit& u, int wr, int wc, int fr, int fq) const {
        const int row0 = u.pm * BM + wr * 64 + fr, col0 = u.pn * BM + wc * 32 + 8 * fq;
#pragma unroll
        for (int ai = 0; ai < 2; ++ai)
#pragma unroll
            for (int m = 0; m < 4; ++m) { const int row = row0 + ai * HALF + m * 16; float s = 0.f;
#pragma unroll
                for (int bj = 0; bj < 2; ++bj) { const size_t off = (size_t)row * 1024 + col0 + bj * HALF; f32x4 b0, b1;
                    if (BASE_BF16) { const u32x4 w = *(const u32x4*)((const bf16_t*)base + off);
                        b0 = (f32x4){__uint_as_float(w.x << 16), __uint_as_float(w.x & 0xffff0000u), __uint_as_float(w.y << 16), __uint_as_float(w.y & 0xffff0000u)};
                        b1 = (f32x4){__uint_as_float(w.z << 16), __uint_as_float(w.z & 0xffff0000u), __uint_as_float(w.w << 16), __uint_as_float(w.w & 0xffff0000u)}; }
                    else { b0 = *(const f32x4*)((const float*)base + off); b1 = *(const f32x4*)((const float*)base + off + 4); }
                    const f32x4 h0 = b0 + acc[ai][bj][m][0], h1 = b1 + acc[ai][bj][m][1];
                    if (WRITE_F32) { *(f32x4*)(out + off) = h0; *(f32x4*)(out + off + 4) = h1; }
                    s += (h0[0] * h0[0] + h0[1] * h0[1]) + (h0[2] * h0[2] + h0[3] * h0[3]) + (h1[0] * h1[0] + h1[1] * h1[1]) + (h1[2] * h1[2] + h1[3] * h1[3]);
                    if (WRITE_B) *(u32x4*)(ob + off) = pack8(h0, h1); }
                s += __shfl_xor(s, 16); s += __shfl_xor(s, 32);
                if (fq == 0) ss[(size_t)row * 16 + u.pn * 4 + wc] = s; }
    }
};

template <class Epi, class Sched, bool ALIGN_EPI = false, bool SP2 = false>
__device__ __forceinline__ void gemm_phase(PG8_LAS unsigned char* lds, const Gemm g, const Sched& S, const Epi& E) {
    const int tid = threadIdx.x, wid = __builtin_amdgcn_readfirstlane(tid >> 6), lane = tid & 63, wr = wid >> 2, wc = wid & 3, fr = lane & 15, fq = lane >> 4;
    const int K = g.K, nt = K / BK;
    unsigned voffA[2], voffB[2];
#pragma unroll
    for (int i = 0; i < 2; ++i) { int R, C; stage_rc(tid * 16 + i * 8192, R, C); const int Rb = Epi::PERM ? ((R & ~31) + perm32(R & 31)) : R;
        voffA[i] = (unsigned)(R * K + C) * 2u; voffB[i] = (unsigned)(Rb * K + C) * 2u; }
    const size_t kstep = (size_t)(BK * 2);
    const size_t hstep = (size_t)HALF * K * 2;
    const size_t tstep = 2 * hstep;
    const unsigned ldsw = (unsigned)wid * 1024u;
    const int aoff = lds_byte(wr * 64 + fr, fq * 8), boff = lds_byte(wc * 32 + fr, fq * 8);
#define PG8_SA(b, h) (((b) * 2 + (h)) * HTB)
#define PG8_SB(b, h) ((4 + (b) * 2 + (h)) * HTB)
#define PG8_STAGE(bufoff, gbase, voff) do { _Pragma("unroll") for (int _i = 0; _i < 2; ++_i) \
        __builtin_amdgcn_global_load_lds((const unsigned*)((const char*)(gbase) + (voff)[_i]), (PG8_LAS unsigned*)(lds + (bufoff) + ldsw + _i * 8192), 16, 0, 0); } while (0)
#define PG8_LDA(dst, b, h) do { _Pragma("unroll") for (int m = 0; m < 4; ++m) _Pragma("unroll") for (int k = 0; k < 2; ++k) dst[m][k] = *(const PG8_LAS bf16x8*)(lds + PG8_SA(b, h) + aoff + m * 2048 + k * 1024); } while (0)
#define PG8_LDB(dst, b, h) do { _Pragma("unroll") for (int n = 0; n < 2; ++n) _Pragma("unroll") for (int k = 0; k < 2; ++k) dst[n][k] = *(const PG8_LAS bf16x8*)(lds + PG8_SB(b, h) + boff + n * 2048 + k * 1024); } while (0)
#define PG8_MMA(ai, bj, At, Bt) do { __builtin_amdgcn_s_setprio(1); _Pragma("unroll") for (int m = 0; m < 4; ++m) _Pragma("unroll") for (int n = 0; n < 2; ++n) _Pragma("unroll") for (int k = 0; k < 2; ++k) \
        acc[ai][bj][m][n] = __builtin_amdgcn_mfma_f32_16x16x32_bf16(Bt[n][k], At[m][k], acc[ai][bj][m][n], 0, 0, 0); __builtin_amdgcn_s_setprio(0); } while (0)
#define PG8_WAIT_V(n) asm volatile("s_waitcnt vmcnt(" #n ")" ::: "memory")
#define PG8_WAIT_L(n) asm volatile("s_waitcnt lgkmcnt(" #n ")" ::: "memory")
#define PG8_BAR __builtin_amdgcn_s_barrier()
#define PG8_SCHED __builtin_amdgcn_sched_barrier(0)
    Unit cur, nxt; int ui = 0;
    if (!S.next(0, cur)) return;
    f32x4 acc[2][2][4][2];
#pragma unroll
    for (int a = 0; a < 2; ++a)
#pragma unroll
        for (int b = 0; b < 2; ++b)
#pragma unroll
            for (int m = 0; m < 4; ++m)
#pragma unroll
                for (int n = 0; n < 2; ++n) acc[a][b][m][n] = (f32x4){0.f, 0.f, 0.f, 0.f};
    bf16x8 At[4][2], B0[2][2], B1[2][2];
    const char* cA = (const char*)g.A + (size_t)cur.pm * tstep; const char* cB = (const char*)g.Bt + (size_t)cur.pn * tstep;
    S.a_ready(cur);
    if constexpr (SP2) {
        PG8_STAGE(PG8_SB(0, 0), cB, voffB); PG8_STAGE(PG8_SB(0, 1), cB + hstep, voffB); PG8_STAGE(PG8_SA(0, 0), cA, voffA); PG8_STAGE(PG8_SA(0, 1), cA + hstep, voffA);
        if (wr == 1) PG8_BAR;
        PG8_WAIT_V(2); PG8_BAR;
        PG8_STAGE(PG8_SB(1, 0), cB + kstep, voffB); PG8_STAGE(PG8_SA(1, 0), cA + kstep, voffA); PG8_STAGE(PG8_SB(1, 1), cB + hstep + kstep, voffB);
        PG8_WAIT_V(6); PG8_BAR;
    } else {
        PG8_STAGE(PG8_SB(0, 0), cB, voffB); PG8_STAGE(PG8_SA(0, 0), cA, voffA); PG8_STAGE(PG8_SB(0, 1), cB + hstep, voffB); PG8_STAGE(PG8_SA(0, 1), cA + hstep, voffA);
        if (wr == 1) PG8_BAR;
        PG8_WAIT_V(4); PG8_BAR;
        PG8_STAGE(PG8_SB(1, 0), cB + kstep, voffB); PG8_STAGE(PG8_SA(1, 0), cA + kstep, voffA); PG8_STAGE(PG8_SB(1, 1), cB + hstep + kstep, voffB);
        PG8_WAIT_V(6); PG8_BAR;
    }
    for (;;) {
        const bool has_next = S.next(ui + 1, nxt);
        const char* nA = has_next ? (const char*)g.A + (size_t)nxt.pm * tstep : cA; const char* nB = has_next ? (const char*)g.Bt + (size_t)nxt.pn * tstep : cB;
        for (int t = 0; t < nt; t += 2) {
            const bool last = (t == nt - 2);
            const char* a1 = cA + (size_t)(t + 1) * kstep;
            const char* a2 = last ? nA : cA + (size_t)(t + 2) * kstep; const char* b2 = last ? nB : cB + (size_t)(t + 2) * kstep;
            const char* a3 = a2 + kstep; const char* b3 = b2 + kstep;
            if (last && has_next) S.a_ready(nxt);
            if constexpr (SP2) {
            PG8_LDB(B0, 0, 0); PG8_LDB(B1, 0, 1); PG8_SCHED; PG8_LDA(At, 0, 0); PG8_STAGE(PG8_SA(1, 1), a1 + hstep, voffA);
            PG8_WAIT_V(8); PG8_WAIT_L(0); PG8_BAR; PG8_MMA(0, 0, At, B0); PG8_MMA(0, 1, At, B1); PG8_BAR; PG8_SCHED;
            PG8_LDA(At, 0, 1); PG8_STAGE(PG8_SB(0, 0), b2, voffB); PG8_STAGE(PG8_SB(0, 1), b2 + hstep, voffB); PG8_STAGE(PG8_SA(0, 0), a2, voffA);
            PG8_WAIT_V(8); PG8_WAIT_L(0); PG8_BAR; PG8_MMA(1, 0, At, B0); PG8_MMA(1, 1, At, B1); PG8_BAR; PG8_SCHED;
            PG8_LDB(B0, 1, 0); PG8_LDB(B1, 1, 1); PG8_SCHED; PG8_LDA(At, 1, 0); PG8_STAGE(PG8_SA(0, 1), a2 + hstep, voffA);
            PG8_WAIT_V(8); PG8_WAIT_L(0); PG8_BAR; PG8_MMA(0, 0, At, B0); PG8_MMA(0, 1, At, B1); PG8_BAR; PG8_SCHED;
            PG8_LDA(At, 1, 1); PG8_STAGE(PG8_SB(1, 0), b3, voffB); PG8_STAGE(PG8_SB(1, 1), b3 + hstep, voffB); PG8_STAGE(PG8_SA(1, 0), a3, voffA);
            PG8_WAIT_V(8); PG8_WAIT_L(0); PG8_BAR; PG8_MMA(1, 0, At, B0); PG8_MMA(1, 1, At, B1); PG8_BAR; PG8_SCHED;
            } else {
            PG8_LDB(B0, 0, 0); PG8_SCHED; PG8_LDA(At, 0, 0); PG8_STAGE(PG8_SA(1, 1), a1 + hstep, voffA);
            PG8_WAIT_L(8); PG8_BAR; PG8_WAIT_L(0); PG8_MMA(0, 0, At, B0); PG8_BAR; PG8_SCHED;
            PG8_LDB(B1, 0, 1); PG8_STAGE(PG8_SB(0, 0), b2, voffB);
            PG8_BAR; PG8_WAIT_L(0); PG8_MMA(0, 1, At, B1); PG8_BAR;
            PG8_LDA(At, 0, 1); PG8_STAGE(PG8_SA(0, 0), a2, voffA);
            PG8_BAR; PG8_WAIT_L(0); PG8_MMA(1, 0, At, B0); PG8_BAR; PG8_SCHED;
            PG8_STAGE(PG8_SB(0, 1), b2 + hstep, voffB);
            PG8_WAIT_V(6); PG8_BAR; PG8_MMA(1, 1, At, B1); PG8_BAR;
            PG8_LDB(B0, 1, 0); PG8_SCHED; PG8_LDA(At, 1, 0); PG8_STAGE(PG8_SA(0, 1), a2 + hstep, voffA);
            PG8_WAIT_L(8); PG8_BAR; PG8_WAIT_L(0); PG8_MMA(0, 0, At, B0); PG8_BAR; PG8_SCHED;
            PG8_LDB(B1, 1, 1); PG8_STAGE(PG8_SB(1, 0), b3, voffB);
            PG8_BAR; PG8_WAIT_L(0); PG8_MMA(0, 1, At, B1); PG8_BAR;
            PG8_LDA(At, 1, 1); PG8_STAGE(PG8_SA(1, 0), a3, voffA);
            PG8_BAR; PG8_WAIT_L(0); PG8_MMA(1, 0, At, B0); PG8_BAR; PG8_SCHED;
            PG8_STAGE(PG8_SB(1, 1), b3 + hstep, voffB);
            PG8_WAIT_V(6); PG8_BAR; PG8_MMA(1, 1, At, B1); PG8_BAR;
            }
        }
        if constexpr (ALIGN_EPI) { if (wr == 0) PG8_BAR; }
        if constexpr (!Epi::AFTER_DRAIN) { E(acc, cur, wr, wc, fr, fq); S.done(cur); }
        if (!has_next) break;
#pragma unroll
        for (int a = 0; a < 2; ++a)
#pragma unroll
            for (int b = 0; b < 2; ++b)
#pragma unroll
                for (int m = 0; m < 4; ++m)
#pragma unroll
                    for (int n = 0; n < 2; ++n) acc[a][b][m][n] = (f32x4){0.f, 0.f, 0.f, 0.f};
        cur = nxt; cA = nA; cB = nB; ++ui;
        if constexpr (ALIGN_EPI) { if (wr == 1) PG8_BAR; }
    }
    PG8_WAIT_V(0);
    if constexpr (!ALIGN_EPI) { if (wr == 0) PG8_BAR; }
    PG8_BAR;
    if constexpr (Epi::AFTER_DRAIN) { E.fused(acc, cur, wr, wc, fr, fq, lds, wid, lane); S.done(cur); }
#undef PG8_SA
#undef PG8_SB
#undef PG8_STAGE
#undef PG8_LDA
#undef PG8_LDB
#undef PG8_MMA
#undef PG8_WAIT_V
#undef PG8_WAIT_L
#undef PG8_BAR
#undef PG8_SCHED
}
}

constexpr int NWAVES = 8, NTHR = NWAVES * 64;
constexpr int M = 65536, SEQ = 4096, D = 1024, INC = 2560, FF = 4096, NMEM = 256, MROWS = 4096  ;
constexpr float EPS = 1e-6f;
constexpr int NPHASE = 10;
#ifndef MK_N_LAUNCHES
#define MK_N_LAUNCHES 1
#endif
constexpr size_t MiB = 1u << 20;
constexpr size_t WS_RSTD0 = 1 * MiB, WS_RSTDM = 2 * MiB, WS_PWT = 3 * MiB;
constexpr size_t WS_SS1 = 768 * MiB, WS_SS2 = 772 * MiB, WS_SS3 = 776 * MiB;
constexpr size_t WS_WIN = 4 * MiB, WS_WOUT = 9 * MiB, WS_WQ = 11 * MiB, WS_WKV = 13 * MiB, WS_WO = 17 * MiB, WS_WUP = 19 * MiB, WS_WDN = 27 * MiB;
constexpr size_t WS_KB = 36 * MiB, WS_VT = 44 * MiB, WS_MEMB = 52 * MiB;
constexpr size_t WS_BUFA = 64 * MiB;
constexpr size_t WS_U = 192 * MiB;
constexpr size_t WS_LF = 512 * MiB;
constexpr size_t WS_YMIX = 640 * MiB;
constexpr size_t WS_QX = 192 * MiB, WS_OB = 320 * MiB;
constexpr size_t WS_A2 = 192 * MiB;
constexpr size_t WS_SL = 784 * MiB, WS_DL = 800 * MiB;
constexpr size_t WS_END = 801 * MiB;
constexpr int LDS_BYTES = 147456;

typedef unsigned short bf16;
typedef unsigned u32x4 __attribute__((ext_vector_type(4)));
typedef unsigned u32x2 __attribute__((ext_vector_type(2)));
typedef float f32x4 __attribute__((ext_vector_type(4)));
typedef short bf16x8 __attribute__((ext_vector_type(8)));
#define MFMA16(a, b, c) __builtin_amdgcn_mfma_f32_16x16x32_bf16((a), (b), (c), 0, 0, 0)
__device__ __forceinline__ f32x4 mfma_safe(bf16x8 a, bf16x8 b, f32x4 c) { f32x4 d = MFMA16(a, b, c); asm volatile("" : "+v"(d) : "v"(a), "v"(b)); return d; }
__device__ __forceinline__ float bflo(unsigned w) { return __uint_as_float(w << 16); }
__device__ __forceinline__ float bfhi(unsigned w) { return __uint_as_float(w & 0xffff0000u); }
__device__ __forceinline__ unsigned pk2(float lo, float hi) { return pg8::cvt_pk_bf16(lo, hi); }
__device__ __forceinline__ float wave_sum(float v) {
#pragma unroll
    for (int o = 1; o < 64; o <<= 1) v += __shfl_xor(v, o);
    return v;
}
#define LDS_FENCE() asm volatile("s_waitcnt lgkmcnt(0)" ::: "memory")
__device__ __forceinline__ f32x4 zero_acc() { f32x4 z = {0.f, 0.f, 0.f, 0.f}; asm volatile("" : "+v"(z)); return z; }

__device__ __forceinline__ void p0_transpose_item(const float* W, int K, int N, const float* gain, bf16* WT, float* scr, int item, int lane) {
    const int nblk = N / 32, kb = item / nblk, nb = item % nblk, k0 = 64 * kb, n0 = 32 * nb;
#pragma unroll 8
    for (int i = 0; i < 32; ++i) { const int kk = 2 * i + (lane >> 5); const float g = gain ? gain[k0 + kk] : 1.0f; scr[kk * 33 + (lane & 31)] = W[(size_t)(k0 + kk) * N + n0 + (lane & 31)] * g; }
    LDS_FENCE();
    const int c = lane & 7;
#pragma unroll
    for (int j = 0; j < 4; ++j) { const int n = (lane >> 3) + 8 * j; const float* s = scr + (8 * c) * 33 + n;
        u32x4 o; o.x = pk2(s[0 * 33], s[1 * 33]); o.y = pk2(s[2 * 33], s[3 * 33]); o.z = pk2(s[4 * 33], s[5 * 33]); o.w = pk2(s[6 * 33], s[7 * 33]);
        *(u32x4*)(WT + (size_t)(n0 + n) * K + k0 + 8 * c) = o; }
    LDS_FENCE();
}
__device__ __forceinline__ void p0_row(const float* xrow, bf16* orow, float* rstd_out, int lane) {
    const f32x4* xr = (const f32x4*)xrow + lane;
    f32x4 v[4]; float s = 0.f;
#pragma unroll
    for (int j = 0; j < 4; ++j) { v[j] = xr[64 * j]; s += (v[j][0] * v[j][0] + v[j][1] * v[j][1]) + (v[j][2] * v[j][2] + v[j][3] * v[j][3]); }
    s = wave_sum(s);
    u32x2* o8 = (u32x2*)orow + lane;
#pragma unroll
    for (int j = 0; j < 4; ++j) { u32x2 w; w.x = pk2(v[j][0], v[j][1]); w.y = pk2(v[j][2], v[j][3]); o8[64 * j] = w; }
    if (lane == 0) *rstd_out = rsqrtf(s * (1.0f / D) + EPS);
}

template <int G> __device__ __forceinline__ void pool_wave_unit(int tb, const bf16* U, bf16* Y, int lane) {
    constexpr int W = 2 << G;
    const int fr = lane & 15, fq = lane >> 4;
    const int row = tb * 16 + fr, t = row & (SEQ - 1);
    const int nwin = (t + 1 < W) ? (t + 1) : W; const float inv = 1.0f / (float)nwin;
    bf16x8 pf[4];
#pragma unroll
    for (int ks = 0; ks < 4; ++ks) {
        const bf16* p = U + (size_t)row * 512 + G * 128 + ks * 32 + 8 * fq;
        float a[8];
#pragma unroll
        for (int j = 0; j < 8; ++j) a[j] = 0.f;
        u32x4 cur = *(const u32x4*)p;
#pragma unroll
        for (int s = 0; s < W; ++s) { u32x4 v = *(const u32x4*)(p - (size_t)((s < nwin) ? s : 0) * 512);
            if (s >= nwin) v = (u32x4){0u, 0u, 0u, 0u};
#pragma unroll
            for (int e = 0; e < 4; ++e) { a[2 * e] += bflo(v[e]); a[2 * e + 1] += bfhi(v[e]); } }
        u32x4 o;
#pragma unroll
        for (int e = 0; e < 4; ++e) o[e] = pk2(a[2 * e] * inv - bflo(cur[e]), a[2 * e + 1] * inv - bfhi(cur[e]));
        pf[ks] = __builtin_bit_cast(bf16x8, o);
    }
#pragma unroll
    for (int ks = 0; ks < 4; ++ks) *(bf16x8*)(Y + (size_t)row * D + G * 128 + ks * 32 + 8 * fq) = pf[ks];
}

constexpr int H_QR = 0, H_KR = 17408, H_QG = 34816, H_KET = 52224, H_VT = 70656, H_P = 89088, H_O = 98304, H_WT = 132096, H_DEC = 136192;
static_assert(H_DEC + 512 <= LDS_BYTES, "hgrn LDS map");
template <bool STATE_ONLY>
__device__ __forceinline__ void hgrn_unit(unsigned char* lds, int b, int h, int seg, const bf16* U, const float* LF, const float* gnorm, bf16* Y, float* SL, float* DL) {
#define HG_BAR() do { asm volatile("s_waitcnt lgkmcnt(0)" ::: "memory"); __builtin_amdgcn_s_barrier(); asm volatile("" ::: "memory"); } while (0)
    const int tid = threadIdx.x, lane = tid & 63, w = tid >> 6, fr = lane & 15, fq = lane >> 4;
    const int dkg = tid & 15, tp = tid >> 4, dk0 = 8 * dkg, t0 = 2 * tp;
    bf16* Qr = (bf16*)(lds + H_QR); bf16* Kr = (bf16*)(lds + H_KR); bf16* Qg = (bf16*)(lds + H_QG); bf16* KeT = (bf16*)(lds + H_KET); bf16* Vt = (bf16*)(lds + H_VT); bf16* P = (bf16*)(lds + H_P);
    float* O = (float*)(lds + H_O); float* WT = (float*)(lds + H_WT); float* DEC = (float*)(lds + H_DEC);
    f32x4 S[8];
#pragma unroll
    for (int i = 0; i < 8; ++i) S[i] = (f32x4){0.f, 0.f, 0.f, 0.f};
    const int bh = b * 4 + h, c0 = seg * 16, c1 = c0 + 16;
    if constexpr (!STATE_ONLY) {
        for (int js = 0; js < seg; ++js)
#pragma unroll
            for (int i = 0; i < 8; ++i) { const f32x4 dl = *(const f32x4*)(DL + (size_t)(bh * 4 + js) * 128 + 16 * i + 4 * fq); const f32x4 sl = *(const f32x4*)(SL + ((size_t)((bh * 4 + js) * 8 + i) * NTHR + tid) * 4);
                S[i] = S[i] * (f32x4){__expf(dl[0]), __expf(dl[1]), __expf(dl[2]), __expf(dl[3])} + sl; }
    }
    float gsum[8];
#pragma unroll
    for (int j = 0; j < 8; ++j) gsum[j] = 0.f;
    constexpr size_t HSTR = (size_t)64 * 4096 * 128;
    u32x4 rq[2], rk[2], rv[2], rg[2]; f32x4 rl[2][2];
#define HG_LOAD(c) do { _Pragma("unroll") for (int tt = 0; tt < 2; ++tt) { const size_t o_ = ((size_t)bh * SEQ + (size_t)(c) * 64 + t0 + tt) * 128 + dk0; \
        if (!STATE_ONLY) rq[tt] = *(const u32x4*)(U + o_); rk[tt] = *(const u32x4*)(U + HSTR + o_); rv[tt] = *(const u32x4*)(U + 2 * HSTR + o_); \
        const float* lp = LF + o_; rl[tt][0] = *(const f32x4*)lp; rl[tt][1] = *(const f32x4*)(lp + 4); } } while (0)
#define HG_LOADG(c) do { _Pragma("unroll") for (int tt = 0; tt < 2; ++tt) { const size_t o_ = ((size_t)bh * SEQ + (size_t)(c) * 64 + t0 + tt) * 128 + dk0; rg[tt] = *(const u32x4*)(U + 3 * HSTR + o_); } } while (0)
    HG_LOAD(c0);
    for (int c = c0; c < c1; ++c) {
        float a[8], bs[8];
#pragma unroll
        for (int j = 0; j < 8; ++j) { a[j] = rl[0][j >> 2][j & 3]; bs[j] = a[j] + rl[1][j >> 2][j & 3]; }
        float x[8];
#pragma unroll
        for (int j = 0; j < 8; ++j) { x[j] = bs[j]; float y = __shfl_up(x[j], 16); if (lane >= 16) x[j] += y; y = __shfl_up(x[j], 32); if (lane >= 32) x[j] += y; }
        if (lane >= 48) { *(f32x4*)(WT + w * 128 + dk0) = (f32x4){x[0], x[1], x[2], x[3]}; *(f32x4*)(WT + w * 128 + dk0 + 4) = (f32x4){x[4], x[5], x[6], x[7]}; }
        HG_BAR();
        float base[8], gmid[8], glast[8];
#pragma unroll
        for (int j = 0; j < 8; ++j) { base[j] = 0.f; gmid[j] = 0.f; glast[j] = 0.f; }
#pragma unroll
        for (int w2 = 0; w2 < 8; ++w2) { const f32x4 v0 = *(const f32x4*)(WT + w2 * 128 + dk0), v1 = *(const f32x4*)(WT + w2 * 128 + dk0 + 4);
#pragma unroll
            for (int j = 0; j < 8; ++j) { const float tv = (j < 4) ? v0[j & 3] : v1[j & 3]; if (w2 < w) base[j] += tv; if (w2 < 4) gmid[j] += tv; glast[j] += tv; } }
        float ke[2][8];
        {
            float emid[8], elm[8];
#pragma unroll
            for (int j = 0; j < 8; ++j) { emid[j] = __expf(gmid[j]); elm[j] = __expf(glast[j] - gmid[j]); base[j] += x[j] - bs[j]; if (STATE_ONLY) gsum[j] += glast[j]; }
            if (tp == 0) { *(f32x4*)(DEC + dk0) = (f32x4){emid[0] * elm[0], emid[1] * elm[1], emid[2] * elm[2], emid[3] * elm[3]}; *(f32x4*)(DEC + dk0 + 4) = (f32x4){emid[4] * elm[4], emid[5] * elm[5], emid[6] * elm[6], emid[7] * elm[7]}; }
#pragma unroll
            for (int tt = 0; tt < 2; ++tt) { float qr[8], kr[8], qg[8];
#pragma unroll
                for (int j = 0; j < 8; ++j) { const float Gv = base[j] + (tt ? bs[j] : a[j]);
                    const float e1 = __expf(Gv - gmid[j]), e2 = __builtin_amdgcn_rcpf(e1);
                    const unsigned qw = STATE_ONLY ? 0u : rq[tt][j >> 1], kw = rk[tt][j >> 1];
                    const float q = (j & 1) ? bfhi(qw) : bflo(qw), k = (j & 1) ? bfhi(kw) : bflo(kw);
                    qr[j] = q * e1; kr[j] = k * e2; ke[tt][j] = kr[j] * elm[j]; qg[j] = qr[j] * emid[j]; }
                if constexpr (!STATE_ONLY) { const int t = t0 + tt;
                *(u32x4*)(Qr + t * 136 + dk0) = (u32x4){pk2(qr[0], qr[1]), pk2(qr[2], qr[3]), pk2(qr[4], qr[5]), pk2(qr[6], qr[7])};
                *(u32x4*)(Kr + t * 136 + dk0) = (u32x4){pk2(kr[0], kr[1]), pk2(kr[2], kr[3]), pk2(kr[4], kr[5]), pk2(kr[6], kr[7])};
                *(u32x4*)(Qg + t * 136 + dk0) = (u32x4){pk2(qg[0], qg[1]), pk2(qg[2], qg[3]), pk2(qg[4], qg[5]), pk2(qg[6], qg[7])}; }
                __builtin_amdgcn_sched_barrier(0); }
        }
#pragma unroll
        for (int j = 0; j < 8; ++j) { const int tsw = ((((t0 >> 3) ^ (dkg & 7)) << 3) | (t0 & 7));
            *(unsigned*)(KeT + (dk0 + j) * 72 + tsw) = pk2(ke[0][j], ke[1][j]);
            const unsigned v0 = rv[0][j >> 1], v1 = rv[1][j >> 1];
            *(unsigned*)(Vt + (dk0 + j) * 72 + tsw) = (j & 1) ? ((v0 >> 16) | (v1 & 0xffff0000u)) : ((v0 & 0xffffu) | (v1 << 16)); }
        HG_BAR();
        if constexpr (!STATE_ONLY) HG_LOADG(c);
        if (c + 1 < c1) HG_LOAD(c + 1);
        if constexpr (!STATE_ONLY) { const int ti = w >> 1;
#pragma unroll
          for (int s2 = 0; s2 < 2; ++s2) { const int si = 2 * (w & 1) + s2; u32x2 pw; pw.x = 0u; pw.y = 0u;
              if (si <= ti) { f32x4 sc = zero_acc();
#pragma unroll
                  for (int ks = 0; ks < 4; ++ks) { const bf16x8 kf = *(const bf16x8*)(Kr + (si * 16 + fr) * 136 + ks * 32 + 8 * fq), qf = *(const bf16x8*)(Qr + (ti * 16 + fr) * 136 + ks * 32 + 8 * fq); sc = mfma_safe(kf, qf, sc); }
                  const int tix = ti * 16 + fr, six = si * 16 + 4 * fq;
#pragma unroll
                  for (int i = 0; i < 4; ++i) if (six + i > tix) sc[i] = 0.f;
                  pw.x = pk2(sc[0], sc[1]); pw.y = pk2(sc[2], sc[3]); }
              *(u32x2*)(P + (ti * 16 + fr) * 72 + si * 16 + 4 * fq) = pw; } }
        f32x4 ao[4];
        if constexpr (!STATE_ONLY) { bf16x8 Sb[4];
#pragma unroll
          for (int kk = 0; kk < 4; ++kk) { u32x4 o; o.x = pk2(S[2 * kk][0], S[2 * kk][1]); o.y = pk2(S[2 * kk][2], S[2 * kk][3]); o.z = pk2(S[2 * kk + 1][0], S[2 * kk + 1][1]); o.w = pk2(S[2 * kk + 1][2], S[2 * kk + 1][3]); Sb[kk] = __builtin_bit_cast(bf16x8, o); }
#pragma unroll
          for (int tt = 0; tt < 4; ++tt) { ao[tt] = zero_acc();
#pragma unroll
              for (int kk = 0; kk < 4; ++kk) { const bf16* qp = Qg + (tt * 16 + fr) * 136 + 32 * kk + 4 * fq; const u32x2 lo = *(const u32x2*)qp, hi = *(const u32x2*)(qp + 16);
                  const u32x4 af = {lo.x, lo.y, hi.x, hi.y}; ao[tt] = mfma_safe(__builtin_bit_cast(bf16x8, af), Sb[kk], ao[tt]); } } }
        bf16x8 Vf[2];
#pragma unroll
        for (int ks = 0; ks < 2; ++ks) Vf[ks] = *(const bf16x8*)(Vt + (16 * w + fr) * 72 + (((ks * 4 + fq) ^ ((2 * w + (fr >> 3)) & 7)) << 3));
#pragma unroll
        for (int i = 0; i < 8; ++i) { const f32x4 dc = *(const f32x4*)(DEC + 16 * i + 4 * fq); S[i] = S[i] * dc;
#pragma unroll
            for (int ks = 0; ks < 2; ++ks) { const bf16x8 kf = *(const bf16x8*)(KeT + (16 * i + fr) * 72 + (((ks * 4 + fq) ^ ((2 * i + (fr >> 3)) & 7)) << 3)); S[i] = mfma_safe(kf, Vf[ks], S[i]); } }
        if constexpr (!STATE_ONLY) {
        HG_BAR();
#pragma unroll
        for (int tt = 0; tt < 4; ++tt)
#pragma unroll
            for (int ks = 0; ks < 2; ++ks) { const bf16x8 pf = *(const bf16x8*)(P + (tt * 16 + fr) * 72 + ks * 32 + 8 * fq); ao[tt] = mfma_safe(pf, Vf[ks], ao[tt]); }
#pragma unroll
        for (int tt = 0; tt < 4; ++tt)
#pragma unroll
            for (int i = 0; i < 4; ++i) O[(tt * 16 + 4 * fq + i) * 132 + 16 * w + fr] = ao[tt][i];
        HG_BAR();
        f32x4 gn[2]; gn[0] = *(const f32x4*)(gnorm + h * 128 + dk0); gn[1] = *(const f32x4*)(gnorm + h * 128 + dk0 + 4);
#pragma unroll
        for (int tt = 0; tt < 2; ++tt) { const int t = t0 + tt; const f32x4 o0 = *(const f32x4*)(O + t * 132 + dk0), o1 = *(const f32x4*)(O + t * 132 + dk0 + 4);
            float ssq = (o0[0] * o0[0] + o0[1] * o0[1]) + (o0[2] * o0[2] + o0[3] * o0[3]) + (o1[0] * o1[0] + o1[1] * o1[1]) + (o1[2] * o1[2] + o1[3] * o1[3]);
            ssq += __shfl_xor(ssq, 1); ssq += __shfl_xor(ssq, 2); ssq += __shfl_xor(ssq, 4); ssq += __shfl_xor(ssq, 8);
            const float rs = rsqrtf(ssq * (1.0f / 128.0f) + EPS);
            u32x4 ow;
#pragma unroll
            for (int e = 0; e < 4; ++e) { const unsigned gw = rg[tt][e]; const float oa = (e < 2) ? o0[2 * e] : o1[2 * e - 4], ob = (e < 2) ? o0[2 * e + 1] : o1[2 * e - 3];
                const float ga = (e < 2) ? gn[0][2 * e] : gn[1][2 * e - 4], gb = (e < 2) ? gn[0][2 * e + 1] : gn[1][2 * e - 3];
                ow[e] = pk2(oa * rs * ga * bflo(gw), ob * rs * gb * bfhi(gw)); }
            *(u32x4*)(Y + ((size_t)b * SEQ + (size_t)c * 64 + t) * D + 512 + h * 128 + dk0) = ow; }
        }
    }
    if constexpr (STATE_ONLY) {
#pragma unroll
        for (int i = 0; i < 8; ++i) *(f32x4*)(SL + ((size_t)((bh * 4 + seg) * 8 + i) * NTHR + tid) * 4) = S[i];
        if (tp == 0) { *(f32x4*)(DL + (size_t)(bh * 4 + seg) * 128 + dk0) = (f32x4){gsum[0], gsum[1], gsum[2], gsum[3]}; *(f32x4*)(DL + (size_t)(bh * 4 + seg) * 128 + dk0 + 4) = (f32x4){gsum[4], gsum[5], gsum[6], gsum[7]}; }
    }
#undef HG_LOAD
#undef HG_LOADG
#undef HG_BAR
}

constexpr int AT_QS = 0, AT_PS = 67584, AT_MX = 135168, AT_LS = AT_MX + 4096;
static_assert(AT_LS + 4096 <= LDS_BYTES - 16, "attention LDS map");
__device__ __forceinline__ void attn_wg(unsigned char* lds, int bx, const bf16* Q, const bf16* Kb, const bf16* Vt, bf16* Ob) {
    const int tid = threadIdx.x, lane = tid & 63, w = tid >> 6, fr = lane & 15, fq = lane >> 4;
    const int bh = bx >> 2, b = bh >> 2, h = bh & 3;
    const size_t rowbase = (size_t)b * SEQ + (size_t)(bx & 3) * 1024;
    unsigned char* Qs = lds + AT_QS; unsigned char* Ps = lds + AT_PS; float* MX = (float*)(lds + AT_MX); float* LS = (float*)(lds + AT_LS);
#define AT_BAR() do { asm volatile("s_waitcnt lgkmcnt(0)" ::: "memory"); __builtin_amdgcn_s_barrier(); asm volatile("" ::: "memory"); } while (0)
    bf16x8 Kf[2][8], Vf[2][8];
#pragma unroll
    for (int t = 0; t < 2; ++t)
#pragma unroll
        for (int ks = 0; ks < 8; ++ks) { Kf[t][ks] = *(const bf16x8*)(Kb + (size_t)(b * NMEM + 32 * w + 16 * t + fr) * D + h * 256 + ks * 32 + 8 * fq);
                                         Vf[t][ks] = *(const bf16x8*)(Vt + (size_t)(h * 256 + 32 * w + 16 * t + fr) * MROWS + b * NMEM + ks * 32 + 8 * fq); }
    u32x4 qs[4];
#define AT_QLOAD(uu) do { const char* qb_ = (const char*)(Q + (rowbase + (size_t)(uu) * 64) * D + h * 256); unsigned qoff = (unsigned)(((tid >> 5) * D + (tid & 31) * 8) * 2); \
        _Pragma("unroll") for (int i = 0; i < 4; ++i) { qs[i] = *(const u32x4*)(qb_ + qoff); qoff += 16 * D * 2; asm volatile("" : "+v"(qoff)); } } while (0)
#define AT_QSTORE() do { _Pragma("unroll") for (int i = 0; i < 4; ++i) { const int p_ = tid + NTHR * i; *(u32x4*)(Qs + (p_ >> 5) * 528 + (p_ & 31) * 16) = qs[i]; } } while (0)
    AT_QLOAD(0); AT_QSTORE(); AT_BAR();
    for (int u = 0; u < 16; ++u) {
        const size_t row0 = rowbase + (size_t)u * 64;
        char* ob_u = (char*)(Ob + row0 * D + h * 256);
        AT_QLOAD(u + 1);
        f32x4 S[2][4];
#pragma unroll
        for (int t = 0; t < 2; ++t)
#pragma unroll
            for (int rt = 0; rt < 4; ++rt) S[t][rt] = zero_acc();
#pragma unroll
        for (int rt = 0; rt < 4; ++rt)
#pragma unroll
            for (int k0 = 0; k0 < 8; k0 += 4) { bf16x8 qf[4];
#pragma unroll
                for (int k = 0; k < 4; ++k) qf[k] = *(const bf16x8*)(Qs + (rt * 16 + fr) * 528 + ((k0 + k) * 32 + 8 * fq) * 2);
                __builtin_amdgcn_sched_barrier(0);
#pragma unroll
                for (int k = 0; k < 4; ++k) { S[0][rt] = MFMA16(Kf[0][k0 + k], qf[k], S[0][rt]); S[1][rt] = MFMA16(Kf[1][k0 + k], qf[k], S[1][rt]); }
                __builtin_amdgcn_sched_barrier(0); }
#pragma unroll
        for (int rt = 0; rt < 4; ++rt) { float m = fmaxf(fmaxf(fmaxf(S[0][rt][0], S[0][rt][1]), fmaxf(S[0][rt][2], S[0][rt][3])), fmaxf(fmaxf(S[1][rt][0], S[1][rt][1]), fmaxf(S[1][rt][2], S[1][rt][3])));
            m = fmaxf(m, __shfl_xor(m, 16)); m = fmaxf(m, __shfl_xor(m, 32));
            if (fq == 0) MX[w * 64 + rt * 16 + fr] = m;
            __builtin_amdgcn_sched_barrier(0); }
        AT_BAR();
#pragma unroll
        for (int rt = 0; rt < 4; ++rt) { float gm = MX[rt * 16 + fr];
#pragma unroll
            for (int w2 = 1; w2 < 8; ++w2) gm = fmaxf(gm, MX[w2 * 64 + rt * 16 + fr]);
            float l = 0.f;
#pragma unroll
            for (int t = 0; t < 2; ++t) {
#pragma unroll
                for (int i = 0; i < 4; ++i) { const float p = __builtin_amdgcn_exp2f(S[t][rt][i] - gm); S[t][rt][i] = p; l += p; }
                u32x2 o; o.x = pk2(S[t][rt][0], S[t][rt][1]); o.y = pk2(S[t][rt][2], S[t][rt][3]);
                *(u32x2*)(Ps + (rt * 16 + fr) * 528 + (32 * w + 16 * t + 4 * fq) * 2) = o; }
            l += __shfl_xor(l, 16); l += __shfl_xor(l, 32);
            if (fq == 0) LS[w * 64 + rt * 16 + fr] = l;
            __builtin_amdgcn_sched_barrier(0); }
        AT_BAR();
        AT_QSTORE();
        f32x4 Oa[2][4];
#pragma unroll
        for (int t = 0; t < 2; ++t)
#pragma unroll
            for (int rt = 0; rt < 4; ++rt) Oa[t][rt] = zero_acc();
#pragma unroll
        for (int rt = 0; rt < 4; ++rt)
#pragma unroll
            for (int k0 = 0; k0 < 8; k0 += 4) { bf16x8 pf[4];
#pragma unroll
                for (int k = 0; k < 4; ++k) pf[k] = *(const bf16x8*)(Ps + (rt * 16 + fr) * 528 + ((k0 + k) * 32 + 8 * fq) * 2);
                __builtin_amdgcn_sched_barrier(0);
#pragma unroll
                for (int k = 0; k < 4; ++k) { Oa[0][rt] = MFMA16(Vf[0][k0 + k], pf[k], Oa[0][rt]); Oa[1][rt] = MFMA16(Vf[1][k0 + k], pf[k], Oa[1][rt]); }
                __builtin_amdgcn_sched_barrier(0); }
        unsigned ooff = (unsigned)((fr * D + 32 * w + 4 * fq) * 2);
#pragma unroll
        for (int rt = 0; rt < 4; ++rt) { float l = LS[rt * 16 + fr];
#pragma unroll
            for (int w2 = 1; w2 < 8; ++w2) l += LS[w2 * 64 + rt * 16 + fr];
            const float inv = 1.0f / l;
#pragma unroll
            for (int t = 0; t < 2; ++t) { u32x2 o; o.x = pk2(Oa[t][rt][0] * inv, Oa[t][rt][1] * inv); o.y = pk2(Oa[t][rt][2] * inv, Oa[t][rt][3] * inv);
                *(u32x2*)(ob_u + ooff + t * 32) = o; }
            ooff += 16 * D * 2; asm volatile("" : "+v"(ooff));
            __builtin_amdgcn_sched_barrier(0); }
        AT_BAR();
    }
#undef AT_BAR
#undef AT_QLOAD
#undef AT_QSTORE
}

#define LAS __attribute__((address_space(3)))
#define XB_TMO      128
#define XB_XCNT(j)  (256  + 64 * (j))
#define XB_XSUB(j)  (1280 + 64 * (j))
#define XB_XGEN(j)  (2304 + 64 * (j))
#define XB_TOP      3328
#define XB_TOPGEN   3392
#define XCD_BAR_WORDS 3456
#define XB_SPIN_CAP (1u << 18)

__device__ __forceinline__ unsigned xb_ld(unsigned* p)              { return __hip_atomic_load(p, __ATOMIC_RELAXED, __HIP_MEMORY_SCOPE_AGENT); }
__device__ __forceinline__ unsigned xb_add(unsigned* p, unsigned v) { return __hip_atomic_fetch_add(p, v, __ATOMIC_RELAXED, __HIP_MEMORY_SCOPE_AGENT); }
__device__ __forceinline__ unsigned xb_xcc_id() { return (unsigned)__builtin_amdgcn_s_getreg((3 << 11) | 20) & 0xFu; }
#define XB_SPIN(cond, bar) do { unsigned _sp = 0; while (cond) { __builtin_amdgcn_s_sleep(1); \
    if ((++_sp & 255u) == 0u) { if (xb_ld(&(bar)[XB_TMO])) break; if (_sp > XB_SPIN_CAP) { atomicAdd(&(bar)[XB_TMO], 1u); break; } } } } while (0)

struct XcdBarrier {
    unsigned* bar; unsigned x;
    volatile LAS unsigned* st;
};

__device__ __forceinline__ XcdBarrier xcd_barrier_post(unsigned* bar, volatile LAS unsigned* st) {
    XcdBarrier b; b.bar = bar; b.x = xb_xcc_id(); b.st = st;
    if (threadIdx.x == 0) (void)xb_add(&bar[XB_XCNT(b.x)], 1u);
    return b;
}
__device__ __forceinline__ void xcd_barrier_complete(unsigned* bar, unsigned x, unsigned& nloc, unsigned& nx) {
    const unsigned G = gridDim.x * gridDim.y * gridDim.z;
    unsigned sum, cnt, mine, sp = 0u;
    for (;;) {
        sum = 0u; cnt = 0u; mine = 0u;
#pragma unroll
        for (unsigned j = 0; j < 16; ++j) { const unsigned c = xb_ld(&bar[XB_XCNT(j)]); sum += c; cnt += (c > 0u) ? 1u : 0u; mine = (j == x) ? c : mine; }
        if (sum == G) break;
        __builtin_amdgcn_s_sleep(1);
        if ((++sp & 255u) == 0u) { if (xb_ld(&bar[XB_TMO])) break; if (sp > XB_SPIN_CAP) { atomicAdd(&bar[XB_TMO], 1u); break; } }
    }
    nloc = mine > 0u ? mine : 1u; nx = cnt > 0u ? cnt : 1u;
}

__device__ __forceinline__ void xcd_barrier(const XcdBarrier& b) {
    asm volatile("s_waitcnt vmcnt(0)" ::: "memory");
    __syncthreads();
    if (threadIdx.x == 0) {
        unsigned* bar = b.bar;
        __builtin_amdgcn_s_waitcnt(0);
        unsigned nloc = b.st[0], nx = b.st[1];
        if (nloc == 0u) { xcd_barrier_complete(bar, b.x, nloc, nx); b.st[0] = nloc; b.st[1] = nx; }
        const unsigned old = xb_add(&bar[XB_XSUB(b.x)], 1u);
        const unsigned gen = old / nloc;
        if (old + 1u == (gen + 1u) * nloc) {
            __builtin_amdgcn_fence(__ATOMIC_RELEASE, "agent");
            asm volatile("s_waitcnt vmcnt(0)" ::: "memory");
            const unsigned og = xb_add(&bar[XB_TOP], 1u);
            const unsigned tg = og / nx;
            if (og + 1u == (tg + 1u) * nx) xb_add(&bar[XB_TOPGEN], 1u);
            else XB_SPIN(xb_ld(&bar[XB_TOPGEN]) == tg, bar);
            __builtin_amdgcn_fence(__ATOMIC_ACQUIRE, "agent");
            xb_add(&bar[XB_XGEN(b.x)], 1u);
            asm volatile("s_waitcnt vmcnt(0)" ::: "memory");
        } else {
            XB_SPIN(xb_ld(&bar[XB_XGEN(b.x)]) == gen, bar);
            __builtin_amdgcn_fence(__ATOMIC_ACQUIRE, "agent");
            asm volatile("s_waitcnt vmcnt(0)" ::: "memory");
        }
    }
    __syncthreads();
}

struct Args { const float* in[18]; float* out; unsigned char* ws; int ph_lo, ph_hi; };
__global__ void __launch_bounds__(NTHR, 2) mk_fwd(Args args) {
    extern __shared__ __attribute__((aligned(16))) unsigned char lds[];
    cg::grid_group grid = cg::this_grid();
    PG8_LAS unsigned char* lds3 = (PG8_LAS unsigned char*)lds;
    const int tid = threadIdx.x, lane = tid & 63, wave = __builtin_amdgcn_readfirstlane(tid >> 6);
    const int G = gridDim.x, bx = blockIdx.x;
    unsigned char* ws = args.ws;
    const float* x = args.in[0]; float* out = args.out;
    float* rstd0 = (float*)(ws + WS_RSTD0); float* ss1 = (float*)(ws + WS_SS1); float* ss2 = (float*)(ws + WS_SS2); float* ss3 = (float*)(ws + WS_SS3); float* rstdm = (float*)(ws + WS_RSTDM);
    bf16* PWt = (bf16*)(ws + WS_PWT);
    bf16* Win_t = (bf16*)(ws + WS_WIN); bf16* Wout_t = (bf16*)(ws + WS_WOUT); bf16* Wq_t = (bf16*)(ws + WS_WQ); bf16* Wkv_t = (bf16*)(ws + WS_WKV); bf16* Wo_t = (bf16*)(ws + WS_WO); bf16* Wup_t = (bf16*)(ws + WS_WUP); bf16* Wdn_t = (bf16*)(ws + WS_WDN);
    bf16* Kb = (bf16*)(ws + WS_KB); bf16* Vtg = (bf16*)(ws + WS_VT); bf16* memb = (bf16*)(ws + WS_MEMB);
    bf16* bufA = (bf16*)(ws + WS_BUFA); bf16* Ub = (bf16*)(ws + WS_U); bf16* Hb = (bf16*)(ws + WS_U + 64 * MiB); float* LFb = (float*)(ws + WS_LF); bf16* Ymix = (bf16*)(ws + WS_YMIX);
    bf16* Qx = (bf16*)(ws + WS_QX); bf16* Obuf = (bf16*)(ws + WS_OB); bf16* A2 = (bf16*)(ws + WS_A2);
    const int lo = args.ph_lo, hi = args.ph_hi;
    volatile LAS unsigned* bst = (volatile LAS unsigned*)(lds3 + (LDS_BYTES - 16));
    if (tid < 2) bst[tid] = 0u;
    __syncthreads();
    XcdBarrier xbar; xbar.bar = (unsigned*)ws; xbar.x = xb_xcc_id(); xbar.st = bst;
    if (bx == 0) for (int i = tid; i < XCD_BAR_WORDS; i += NTHR) ((unsigned*)ws)[i] = 0u;
#ifdef DBG_STOP
#define PH_MASK ((2 << DBG_STOP) - 1)
#endif
#ifndef PH_MASK
#define PH_MASK 0x3ff
#endif
#define IN(k) (((PH_MASK >> (k)) & 1) && lo <= (k) && (k) < hi)
#define SEAM(k) do { if (lo <= (k) && (k) + 1 < hi) { if ((k) != 0) { xcd_barrier(xbar); } else { asm volatile("s_waitcnt vmcnt(0) lgkmcnt(0)" ::: "memory"); grid.sync(); __builtin_amdgcn_fence(__ATOMIC_ACQUIRE, "agent"); asm volatile("s_waitcnt vmcnt(0)" ::: "memory"); __builtin_amdgcn_s_barrier(); asm volatile("" ::: "memory"); } } } while (0)

    if (IN(0)) {
        float* scr = (float*)(lds + wave * 16384);
        const int gw = bx * NWAVES + wave, NGW = G * NWAVES;
        constexpr int I_IN = (D / 64) * (INC / 32), I_SQ = (D / 64) * (D / 32), I_KV = (D / 64) * (2 * D / 32), I_UP = (D / 64) * (FF / 32), I_DN = (FF / 64) * (D / 32);
        constexpr int NITEMS = I_IN + 3 * I_SQ + I_KV + I_UP + I_DN;
        for (int it = gw; it < NITEMS; it += NGW) {
            int r = it;
            if (r < I_IN) { if (r % (INC / 32) >= 16) p0_transpose_item(args.in[3], D, INC, args.in[2], Win_t, scr, r, lane); continue; } r -= I_IN;
            if (r < I_SQ) { p0_transpose_item(args.in[8], D, D, nullptr, Wout_t, scr, r, lane); continue; } r -= I_SQ;
            if (r < I_SQ) { p0_transpose_item(args.in[11], D, D, args.in[9], Wq_t, scr, r, lane); continue; } r -= I_SQ;
            if (r < I_KV) { p0_transpose_item(args.in[12], D, 2 * D, args.in[10], Wkv_t, scr, r, lane); continue; } r -= I_KV;
            if (r < I_SQ) { p0_transpose_item(args.in[13], D, D, nullptr, Wo_t, scr, r, lane); continue; } r -= I_SQ;
            if (r < I_UP) { p0_transpose_item(args.in[15], D, FF, args.in[14], Wup_t, scr, r, lane); continue; } r -= I_UP;
            p0_transpose_item(args.in[16], FF, D, nullptr, Wdn_t, scr, r, lane);
        }
        for (int m = gw; m < M; m += NGW) p0_row(x + (size_t)m * D, bufA + (size_t)m * D, rstd0 + m, lane);
        for (int m = gw; m < MROWS; m += NGW) p0_row(args.in[1] + (size_t)m * D, memb + (size_t)m * D, rstdm + m, lane);
        const int gt = bx * NTHR + tid, NGT = G * NTHR;
        (void)gt; (void)NGT;
        __syncthreads();
        { float* Af = (float*)lds; float* Pf = (float*)(lds + 16 * 129 * 4 + 64);
          for (int tile = bx; tile < 256; tile += G) { const int g = tile & 3, k0 = (tile >> 2) * 16;
              for (int i = 0; i < 4; ++i) { const int idx = tid + NTHR * i, k = idx >> 7, c = idx & 127; Af[k * 129 + c] = args.in[3][(size_t)(k0 + k) * INC + g * 128 + c] * args.in[2][k0 + k]; }
              for (int i = 0; i < 32; ++i) { const int idx = tid + NTHR * i; Pf[idx] = args.in[4][g * 16384 + idx]; }
              __syncthreads();
              const int d = tid & 127, kq = tid >> 7; float acc[4];
#pragma unroll
              for (int i = 0; i < 4; ++i) acc[i] = 0.f;
              for (int c = 0; c < 128; ++c) { const float p = Pf[c * 128 + d];
#pragma unroll
                  for (int i = 0; i < 4; ++i) acc[i] += Af[(kq * 4 + i) * 129 + c] * p; }
              const float sc = args.in[5][g * 128 + d];
              u32x2 o0; o0.x = pk2(acc[0] * sc, acc[1] * sc); o0.y = pk2(acc[2] * sc, acc[3] * sc);
              *(u32x2*)(Win_t + (size_t)(g * 128 + d) * D + k0 + kq * 4) = o0;
              __syncthreads(); } }
    }
    SEAM(0);
    if (tid == 0) (void)xb_add(&xbar.bar[XB_XCNT(xbar.x)], 1u);
    if (IN(1)) {
        pg8::Gemm g{bufA, Win_t, M, INC, D}; pg8::StaticOrder S; S.init(M, INC, G, bx);
        pg8::EpiU E{Ub, Hb, LFb, rstd0, args.in[6]};
        pg8::gemm_phase<pg8::EpiU, pg8::StaticOrder, true, true>(lds3, g, S, E);
    }
    SEAM(1);
    if (IN(2)) {
        float* SLb = (float*)(ws + WS_SL); float* DLb = (float*)(ws + WS_DL);
        if ((bx & 3) != 3) hgrn_unit<true>(lds, bx >> 4, (bx >> 2) & 3, bx & 3, Hb, LFb, args.in[7], Ymix, SLb, DLb);
        {
            const int gw = bx * NWAVES + wave, NGW = G * NWAVES;
            for (int wu = gw; wu < (M / 16) * 4; wu += NGW) { const int g = wu & 3, tb = wu >> 2;
                if (g == 0) pool_wave_unit<0>(tb, Ub, Ymix, lane); else if (g == 1) pool_wave_unit<1>(tb, Ub, Ymix, lane); else if (g == 2) pool_wave_unit<2>(tb, Ub, Ymix, lane); else pool_wave_unit<3>(tb, Ub, Ymix, lane); }
            __syncthreads();
            if ((bx & 3) == 3) {
            const int cc = bx >> 2;
            { pg8::Gemm g{memb, Wkv_t, MROWS, D, D}; pg8::StaticOrder S; S.init(MROWS, D, G, cc);
              pg8::EpiScale<false, false, false> E{Kb, D, rstdm, 0.0625f * 1.44269504088896f};
              pg8::gemm_phase<pg8::EpiScale<false, false, false>, pg8::StaticOrder, true, true>(lds3, g, S, E); }
            { pg8::Gemm g{Wkv_t + (size_t)D * D, memb, D, MROWS, D}; pg8::StaticOrder S; S.init(D, MROWS, G, cc);
              pg8::EpiScale<true, false, false> E{Vtg, MROWS, rstdm, 1.0f};
              pg8::gemm_phase<pg8::EpiScale<true, false, false>, pg8::StaticOrder, true, true>(lds3, g, S, E); }
            }
        }
        xcd_barrier(xbar);
        hgrn_unit<false>(lds, bx >> 4, (bx >> 2) & 3, bx & 3, Hb, LFb, args.in[7], Ymix, SLb, DLb);
    }
    SEAM(2);
    if (IN(3)) {
        pg8::Gemm g{Ymix, Wout_t, M, D, D}; pg8::StaticOrder S; S.init(M, D, G, bx);
        pg8::EpiResid<false, false, true> E{x, nullptr, bufA, ss1};
        pg8::gemm_phase<pg8::EpiResid<false, false, true>, pg8::StaticOrder, true, true>(lds3, g, S, E);
    }
    SEAM(3);
    if (IN(4)) {
        pg8::Gemm g{bufA, Wq_t, M, D, D}; pg8::StaticOrder S; S.init(M, D, G, bx);
        PG8_LAS float* qtab = (PG8_LAS float*)(lds3 + 131072);
        { pg8::Unit uu;
          for (int i = 0; i < 4; ++i) if (S.next(i, uu)) { for (int r = tid; r < 256; r += NTHR) { const f32x4* sp = (const f32x4*)(ss1 + (size_t)(uu.pm * 256 + r) * 16); const f32x4 p0 = sp[0], p1 = sp[1], p2 = sp[2], p3 = sp[3];
              const float ssum = ((p0[0] + p0[1]) + (p0[2] + p0[3])) + ((p1[0] + p1[1]) + (p1[2] + p1[3])) + ((p2[0] + p2[1]) + (p2[2] + p2[3])) + ((p3[0] + p3[1]) + (p3[2] + p3[3]));
              qtab[((uu.pm >> 3) & 3) * 256 + r] = rsqrtf(ssum * (1.0f / 1024.0f) + 1e-6f); } }
          __syncthreads(); }
        pg8::EpiQ E{Qx, qtab};
        pg8::gemm_phase<pg8::EpiQ, pg8::StaticOrder, true, true>(lds3, g, S, E);
    }
    SEAM(4);
    if (IN(5)) {
        attn_wg(lds, bx, Qx, Kb, Vtg, Obuf);
    }
    SEAM(5);
    if (IN(6)) {
        pg8::Gemm g{Obuf, Wo_t, M, D, D}; pg8::StaticOrder S; S.init(M, D, G, bx);
        pg8::EpiResid<true, false, true> E{bufA, nullptr, bufA, ss2};
        pg8::gemm_phase<pg8::EpiResid<true, false, true>, pg8::StaticOrder, true, true>(lds3, g, S, E);
    }
    SEAM(6);
    if (IN(7)) {
        pg8::Gemm g{bufA, Wup_t, M, FF, D}; pg8::StaticOrder S; S.init(M, FF, G, bx);
        pg8::EpiUp E{A2, ss2, {0.f, 0.f, 0.f, 0.f, 0.f, 0.f, 0.f, 0.f}, -1};
        pg8::gemm_phase<pg8::EpiUp, pg8::StaticOrder, true, true>(lds3, g, S, E);
    }
    SEAM(7);
    if (IN(8)) {
        pg8::Gemm g{A2, Wdn_t, M, D, FF}; pg8::StaticOrder S; S.init(M, D, G, bx);
        pg8::EpiResid<true, false, true> E{bufA, nullptr, bufA, ss3};
        pg8::gemm_phase<pg8::EpiResid<true, false, true>, pg8::StaticOrder, true, true>(lds3, g, S, E);
    }
    SEAM(8);
    if (IN(9)) {
        const int gw = bx * NWAVES + wave, NGW = G * NWAVES;
        const f32x4* gf = (const f32x4*)args.in[17] + lane;
        f32x4 gv[4];
#pragma unroll
        for (int j = 0; j < 4; ++j) gv[j] = gf[64 * j];
        for (int m = gw; m < M; m += NGW) { f32x4* o = (f32x4*)(out + (size_t)m * D) + lane; const u32x2* hb = (const u32x2*)(bufA + (size_t)m * D) + lane;
            float sv = (lane < 16) ? ss3[(size_t)m * 16 + lane] : 0.f; sv += __shfl_xor(sv, 1); sv += __shfl_xor(sv, 2); sv += __shfl_xor(sv, 4); sv += __shfl_xor(sv, 8); sv = __shfl(sv, 0); const float rs = rsqrtf(sv * (1.0f / D) + EPS);
#pragma unroll
            for (int j = 0; j < 4; ++j) { const u32x2 w = hb[64 * j]; const f32x4 hv = {bflo(w.x), bfhi(w.x), bflo(w.y), bfhi(w.y)}; o[64 * j] = hv * rs * gv[j]; } }
    }
#ifdef DBG_STOP
    { asm volatile("s_waitcnt vmcnt(0) lgkmcnt(0)" ::: "memory"); grid.sync(); __builtin_amdgcn_fence(__ATOMIC_ACQUIRE, "agent"); asm volatile("s_waitcnt vmcnt(0)" ::: "memory");
      const size_t gt = (size_t)bx * NTHR + tid, NGT = (size_t)G * NTHR;
      for (size_t i = gt; i < (size_t)M * D; i += NGT) { const size_t m = i >> 10, c = i & 1023; float v = 0.f;
          if (DBG_STOP == 0) v = bflo(bufA[i]) + rstd0[m] + bflo(Win_t[i % (2560u * 1024u)]) + bflo(Wup_t[i % (4096u * 1024u)]) + bflo(Wdn_t[(i * 7) % (4096u * 1024u)]) + bflo(Wkv_t[i % (2048u * 1024u)]) + bflo(Wq_t[i % (1024u * 1024u)]) + bflo(Wo_t[i % (1024u * 1024u)]) + bflo(Wout_t[i % (1024u * 1024u)]) + bflo(memb[i % (4096u * 1024u)]) + rstdm[m & 4095];
          if (DBG_STOP == 1) v = bflo(Ub[m * 512 + (c & 511)]) + bflo(Hb[i]) + bflo(Hb[i + 67108864]) + LFb[m * 512 + (c & 511)];
          if (DBG_STOP == 2) { if (DBG_SUB == 0) v = bflo(Ymix[m * D + (c & 511)]); if (DBG_SUB == 1) v = bflo(Ymix[m * D + 512 + (c & 511)]); if (DBG_SUB == 2) v = bflo(Kb[(m & 4095) * D + c]); if (DBG_SUB == 3) v = bflo(Vtg[c * MROWS + (m & 4095)]); if (DBG_SUB == 4) v = bflo(Ymix[i]) + bflo(Kb[(m & 4095) * D + c]) + bflo(Vtg[c * MROWS + (m & 4095)]); }
          if (DBG_STOP == 3) v = out[i] + bflo(bufA[i]) + ss1[m * 16 + (c & 15)];
          if (DBG_STOP == 4) v = bflo(Qx[i]);
          if (DBG_STOP == 5) v = bflo(Obuf[i]);
          if (DBG_STOP == 6) v = out[i] + bflo(bufA[i]) + ss2[m * 16 + (c & 15)];
          if (DBG_STOP == 7) v = bflo(A2[m * FF + c]) + bflo(A2[m * FF + 1024 + c]) + bflo(A2[m * FF + 2048 + c]) + bflo(A2[m * FF + 3072 + c]);
          if (DBG_STOP == 8) v = out[i] + ss3[m * 16 + (c & 15)];
          out[i] = v; } }
#endif
#undef IN
#undef SEAM
}

extern "C" void kernel_launch(void* const* d_in, const int* in_sizes, int n_in, void* d_out, int out_size, void* d_ws, size_t ws_size, hipStream_t stream) {
    static int grid = 0;
    if (grid == 0) {
        if (n_in != 18 || in_sizes[0] != M * D || out_size != M * D || ws_size < WS_END) { fprintf(stderr, "kernel_launch: unexpected shapes (n_in %d, in0 %d, out %d, ws %zu); nothing launched\n", n_in, n_in > 0 ? in_sizes[0] : -1, out_size, ws_size); grid = -1; return; }
        int dev = 0, cus = 0, per_cu = 0;
        if (hipGetDevice(&dev) != hipSuccess || hipDeviceGetAttribute(&cus, hipDeviceAttributeMultiprocessorCount, dev) != hipSuccess) { grid = -1; return; }
        if (hipFuncSetAttribute((const void*)mk_fwd, hipFuncAttributeMaxDynamicSharedMemorySize, LDS_BYTES) != hipSuccess) { fprintf(stderr, "kernel_launch: hipFuncSetAttribute failed\n"); grid = -1; return; }
        if (hipOccupancyMaxActiveBlocksPerMultiprocessor(&per_cu, (const void*)mk_fwd, NTHR, LDS_BYTES) != hipSuccess || per_cu < 1) { fprintf(stderr, "kernel_launch: occupancy query failed (%d)\n", per_cu); (void)hipGetLastError(); grid = -1; return; }
        grid = cus * per_cu;
        if (grid > 256) grid = 256;
        if (grid != 256) { fprintf(stderr, "kernel_launch: this kernel needs exactly 256 co-resident workgroups (got %d); nothing launched\n", grid); grid = -1; return; }
    }
    if (grid < 0) return;
    Args a{};
    for (int i = 0; i < 18; ++i) a.in[i] = (const float*)d_in[i];
    a.out = (float*)d_out; a.ws = (unsigned char*)d_ws;
#if MK_N_LAUNCHES == 1
    a.ph_lo = 0; a.ph_hi = NPHASE;
    void* kargs[] = {&a};
    hipError_t e = hipLaunchCooperativeKernel((const void*)mk_fwd, dim3(grid), dim3(NTHR), kargs, LDS_BYTES, stream);
    if (e != hipSuccess) fprintf(stderr, "kernel_launch: cooperative launch failed: %s (grid %d)\n", hipGetErrorString(e), grid);
#else
    for (int p = 0; p < NPHASE; ++p) { a.ph_lo = p; a.ph_hi = p + 1; hipLaunchKernelGGL(mk_fwd, dim3(grid), dim3(NTHR), LDS_BYTES, stream, a); }
#endif
}
```

```cpp
#include <hip/hip_runtime.h>
#include <hip/hip_cooperative_groups.h>
#include <cstdio>
#include <cstdint>
namespace cg = cooperative_groups;
namespace pg8 {
#define PG8_LAS __attribute__((address_space(3)))
typedef unsigned short bf16_t;
typedef short bf16x8 __attribute__((ext_vector_type(8)));
typedef float f32x4 __attribute__((ext_vector_type(4)));
typedef unsigned u32x4 __attribute__((ext_vector_type(4)));
constexpr int BM = 256, BK = 64, HALF = 128, HTB = HALF * BK * 2  , STAGE_BYTES = 8 * HTB, NXCD = 8, WGM = 8;

__host__ __device__ __forceinline__ int lds_byte(int r, int c) { const int st = (r >> 4) * 2 + (c >> 5), rr = r & 15, cc = c & 31, ob = rr * 64 + cc * 2; return st * 1024 + (ob ^ (((ob >> 9) & 1) << 5)); }
__host__ __device__ __forceinline__ void stage_rc(int b, int& R, int& C) { const int st = b / 1024, sb = b % 1024, swz = sb ^ (((sb >> 9) & 1) << 5); R = (st >> 1) * 16 + swz / 64; C = (st & 1) * 32 + (swz % 64) / 2; }
__host__ __device__ __forceinline__ int perm32(int rho) { const int n = rho >> 4, i = rho & 15; return 8 * (i >> 2) + 4 * n + (i & 3); }

struct Unit { int pm, pn; };
struct Gemm { const bf16_t* A; const bf16_t* Bt; int M, N, K; };

struct StaticOrder {
    int nM, nN, nwg, G, c;
    __host__ __device__ void init(int M, int N, int G_, int c_) { nM = M / BM; nN = N / BM; nwg = nM * nN; G = G_; c = c_; }
    __host__ __device__ bool next(int i, Unit& u) const {
        const long L = (long)i * G + c; if (L >= nwg) return false;
        int wgid = (int)L; { const int q = nwg / NXCD, r = nwg % NXCD, xcd = wgid % NXCD, off = wgid / NXCD; wgid = (xcd < r ? xcd * (q + 1) : r * (q + 1) + (xcd - r) * q) + off; }
        const int nig = WGM * nN, gid = wgid / nig, fm = gid * WGM, gsz = (nM - fm) < WGM ? (nM - fm) : WGM;
        u.pm = fm + ((wgid % nig) % gsz); u.pn = (wgid % nig) / gsz; return true;
    }
    __device__ __forceinline__ void a_ready(const Unit&) const {}
    __device__ __forceinline__ void done(const Unit&) const {}
};

typedef float f32x2c_t __attribute__((ext_vector_type(2))); typedef __bf16 bf16x2c_t __attribute__((ext_vector_type(2)));
__device__ __forceinline__ unsigned cvt_pk_bf16(float lo, float hi) { const f32x2c_t v = {lo, hi}; const bf16x2c_t b = __builtin_convertvector(v, bf16x2c_t); return __builtin_bit_cast(unsigned, b); }
typedef float f32x2 __attribute__((ext_vector_type(2)));
__device__ __forceinline__ float sigmoid_f(float x) { return __builtin_amdgcn_rcpf(1.0f + __expf(-x)); }
__device__ __forceinline__ float silu_f(float x) { return x * sigmoid_f(x); }
__device__ __forceinline__ u32x4 pack8(const f32x4 a, const f32x4 b) { u32x4 w; w.x = cvt_pk_bf16(a[0], a[1]); w.y = cvt_pk_bf16(a[2], a[3]); w.z = cvt_pk_bf16(b[0], b[1]); w.w = cvt_pk_bf16(b[2], b[3]); return w; }

struct EpiU {
    static constexpr bool PERM = true, AFTER_DRAIN = false;
    bf16_t* UP; bf16_t* H; float* LF; const float* rstd; const float* lbt;
    __device__ __forceinline__ void operator()(const f32x4 (&acc)[2][2][4][2], const Unit& u, int wr, int wc, int fr, int fq) const {
        const int row0 = u.pm * BM + wr * 64 + fr, kind = u.pn >> 1, d0 = wc * 32 + 8 * fq;
        if (kind == 0) {
#pragma unroll
            for (int ai = 0; ai < 2; ++ai)
#pragma unroll
                for (int m = 0; m < 4; ++m) { const int row = row0 + ai * HALF + m * 16; const float rs = rstd[row];
#pragma unroll
                    for (int bj = 0; bj < 2; ++bj) *(u32x4*)(UP + (size_t)row * 512 + u.pn * BM + bj * HALF + d0) = pack8(acc[ai][bj][m][0] * rs, acc[ai][bj][m][1] * rs); }
        } else if (kind == 2) {
            f32x4 lb[2][2];
#pragma unroll
            for (int bj = 0; bj < 2; ++bj)
#pragma unroll
                for (int n = 0; n < 2; ++n) { const int c = (u.pn & 1) * BM + bj * HALF + d0 + 4 * n; const f32x4 t0 = *(const f32x4*)(lbt + c), t1 = *(const f32x4*)(lbt + 512 + c);
#pragma unroll
                    for (int e = 0; e < 4; ++e) lb[bj][n][e] = __builtin_amdgcn_rcpf(1.0f + __expf(t1[e] - t0[e])); }
#pragma unroll
            for (int ai = 0; ai < 2; ++ai)
#pragma unroll
                for (int m = 0; m < 4; ++m) { const int row = row0 + ai * HALF + m * 16; const float rs = rstd[row];
#pragma unroll
                    for (int bj = 0; bj < 2; ++bj) { f32x4 lf[2], kk[2];
#pragma unroll
                        for (int n = 0; n < 2; ++n)
#pragma unroll
                            for (int e = 0; e < 4; ++e) { const float z = acc[ai][bj][m][n][e] * rs, l = lb[bj][n][e], f = l + (1.0f - l) * sigmoid_f(z); lf[n][e] = __logf(f); kk[n][e] = 1.0f - f; }
                        const size_t hoff = ((size_t)((row >> 12) * 4 + (u.pn & 1) * 2 + bj) * 4096 + (row & 4095)) * 128 + d0;
                        float* lp = LF + hoff; *(f32x4*)lp = lf[0]; *(f32x4*)(lp + 4) = lf[1];
                        *(u32x4*)(H + (size_t)1 * 64 * 4096 * 128 + hoff) = pack8(kk[0], kk[1]); } }
        } else {
            const bool act = (kind == 1) || (kind == 4);
            bf16_t* Hk = H + (size_t)(kind - 1) * 64 * 4096 * 128;
#pragma unroll
            for (int ai = 0; ai < 2; ++ai)
#pragma unroll
                for (int m = 0; m < 4; ++m) { const int row = row0 + ai * HALF + m * 16; const float rs = rstd[row];
#pragma unroll
                    for (int bj = 0; bj < 2; ++bj) { f32x4 v0 = acc[ai][bj][m][0] * rs, v1 = acc[ai][bj][m][1] * rs;
                        if (act) {
#pragma unroll
                            for (int e = 0; e < 4; ++e) { v0[e] = silu_f(v0[e]); v1[e] = silu_f(v1[e]); } }
                        const size_t hoff = ((size_t)((row >> 12) * 4 + (u.pn & 1) * 2 + bj) * 4096 + (row & 4095)) * 128 + d0;
                        *(u32x4*)(Hk + hoff) = pack8(v0, v1); } }
        }
    }
};
template <bool COLSCALE, bool RELU2, bool FROM_SS> struct EpiScale {
    static constexpr bool PERM = true, AFTER_DRAIN = false;
    bf16_t* O; int ldc; const float* sc; float mul;
    __device__ __forceinline__ void operator()(const f32x4 (&acc)[2][2][4][2], const Unit& u, int wr, int wc, int fr, int fq) const {
        const int row0 = u.pm * BM + wr * 64 + fr, col0 = u.pn * BM + wc * 32 + 8 * fq;
        f32x4 cs[2][2];
        if (COLSCALE) {
#pragma unroll
            for (int bj = 0; bj < 2; ++bj)
#pragma unroll
                for (int n = 0; n < 2; ++n) cs[bj][n] = *(const f32x4*)(sc + col0 + bj * HALF + 4 * n) * mul;
        }
#pragma unroll
        for (int ai = 0; ai < 2; ++ai)
#pragma unroll
            for (int m = 0; m < 4; ++m) { const int row = row0 + ai * HALF + m * 16; float rs = 1.0f;
                if (!COLSCALE) { if (FROM_SS) { const f32x4* sp = (const f32x4*)(sc + (size_t)row * 16); const f32x4 p0 = sp[0], p1 = sp[1], p2 = sp[2], p3 = sp[3];
                        const float ssum = ((p0[0] + p0[1]) + (p0[2] + p0[3])) + ((p1[0] + p1[1]) + (p1[2] + p1[3])) + ((p2[0] + p2[1]) + (p2[2] + p2[3])) + ((p3[0] + p3[1]) + (p3[2] + p3[3]));
                        rs = rsqrtf(ssum * (1.0f / 1024.0f) + 1e-6f) * mul; } else rs = sc[row] * mul; }
#pragma unroll
                for (int bj = 0; bj < 2; ++bj) { f32x4 v0, v1;
                    if (COLSCALE) { v0 = acc[ai][bj][m][0] * cs[bj][0]; v1 = acc[ai][bj][m][1] * cs[bj][1]; } else { v0 = acc[ai][bj][m][0] * rs; v1 = acc[ai][bj][m][1] * rs; }
                    if (RELU2) {
#pragma unroll
                        for (int e = 0; e < 4; ++e) { const float a = fmaxf(v0[e], 0.f), b = fmaxf(v1[e], 0.f); v0[e] = a * a; v1[e] = b * b; } }
                    *(u32x4*)(O + (size_t)row * ldc + col0 + bj * HALF) = pack8(v0, v1); } }
    }
};
struct EpiUp {
    static constexpr bool PERM = true, AFTER_DRAIN = false;
    bf16_t* O; const float* sc; const PG8_LAS float* tab; mutable float rsc[8]; mutable int cpm;
    __device__ __forceinline__ void operator()(const f32x4 (&acc)[2][2][4][2], const Unit& u, int wr, int wc, int fr, int fq) const {
        const int row0 = u.pm * BM + wr * 64 + fr, col0 = u.pn * BM + wc * 32 + 8 * fq;
        if (u.pm != cpm) { cpm = u.pm;
#pragma unroll
            for (int ai = 0; ai < 2; ++ai)
#pragma unroll
                for (int m = 0; m < 4; ++m) rsc[ai * 4 + m] = tab[((u.pm >> 3) & 3) * 256 + wr * 64 + fr + ai * HALF + m * 16]; }
#pragma unroll
        for (int ai = 0; ai < 2; ++ai)
#pragma unroll
            for (int m = 0; m < 4; ++m) { const int row = row0 + ai * HALF + m * 16; const float rs = rsc[ai * 4 + m];
#pragma unroll
                for (int bj = 0; bj < 2; ++bj) { f32x4 v0 = acc[ai][bj][m][0] * rs, v1 = acc[ai][bj][m][1] * rs;
#pragma unroll
                    for (int e = 0; e < 4; ++e) { const float a = fmaxf(v0[e], 0.f), b = fmaxf(v1[e], 0.f); v0[e] = a * a; v1[e] = b * b; }
                    *(u32x4*)(O + (size_t)row * 4096 + col0 + bj * HALF) = pack8(v0, v1); } }
    }
};
struct EpiQ {
    static constexpr bool PERM = true, AFTER_DRAIN = false;
    bf16_t* O; const PG8_LAS float* tab;
    __device__ __forceinline__ void operator()(const f32x4 (&acc)[2][2][4][2], const Unit& u, int wr, int wc, int fr, int fq) const {
        const int rl0 = wr * 64 + fr, col0 = u.pn * BM + wc * 32 + 8 * fq; const PG8_LAS float* t = tab + ((u.pm >> 3) & 3) * 256;
#pragma unroll
        for (int ai = 0; ai < 2; ++ai)
#pragma unroll
            for (int m = 0; m < 4; ++m) { const int rl = rl0 + ai * HALF + m * 16; const float rs = t[rl];
#pragma unroll
                for (int bj = 0; bj < 2; ++bj) *(u32x4*)(O + (size_t)(u.pm * BM + rl) * 1024 + col0 + bj * HALF) = pack8(acc[ai][bj][m][0] * rs, acc[ai][bj][m][1] * rs); }
    }
};
template <bool BASE_BF16, bool WRITE_F32, bool WRITE_B> struct EpiResid {
    static constexpr bool PERM = true, AFTER_DRAIN = false;
    const void* base; float* out; bf16_t* ob; float* ss;
    __device__ __forceinline__ void operator()(const f32x4 (&acc)[2][2][4][2], const Unit& u, int wr, int wc, int fr, int fq) const {
        const int row0 = u.pm * BM + wr * 64 + fr, col0 = u.pn * BM + wc * 32 + 8 * fq;
#pragma unroll
        for (int ai = 0; ai < 2; ++ai)
#pragma unroll
            for (int m = 0; m < 4; ++m) { const int row = row0 + ai * HALF + m * 16; float s = 0.f;
#pragma unroll
                for (int bj = 0; bj < 2; ++bj) { const size_t off = (size_t)row * 1024 + col0 + bj * HALF; f32x4 b0, b1;
                    if (BASE_BF16) { const u32x4 w = *(const u32x4*)((const bf16_t*)base + off);
                        b0 = (f32x4){__uint_as_float(w.x << 16), __uint_as_float(w.x & 0xffff0000u), __uint_as_float(w.y << 16), __uint_as_float(w.y & 0xffff0000u)};
                        b1 = (f32x4){__uint_as_float(w.z << 16), __uint_as_float(w.z & 0xffff0000u), __uint_as_float(w.w << 16), __uint_as_float(w.w & 0xffff0000u)}; }
                    else { b0 = *(const f32x4*)((const float*)base + off); b1 = *(const f32x4*)((const float*)base + off + 4); }
                    const f32x4 h0 = b0 + acc[ai][bj][m][0], h1 = b1 + acc[ai][bj][m][1];
                    if (WRITE_F32) { *(f32x4*)(out + off) = h0; *(f32x4*)(out + off + 4) = h1; }
                    s += (h0[0] * h0[0] + h0[1] * h0[1]) + (h0[2] * h0[2] + h0[3] * h0[3]) + (h1[0] * h1[0] + h1[1] * h1[1]) + (h1[2] * h1[2] + h1[3] * h1[3]);
                    if (WRITE_B) *(u32x4*)(ob + off) = pack8(h0, h1); }
                s += __shfl_xor(s, 16); s += __shfl_xor(s, 32);
                if (fq == 0) ss[(size_t)row * 16 + u.pn * 4 + wc] = s; }
    }
};

template <class Epi, class Sched, bool ALIGN_EPI = false, bool SP2 = false>
__device__ __forceinline__ void gemm_phase(PG8_LAS unsigned char* lds, const Gemm g, const Sched& S, const Epi& E) {
    const int tid = threadIdx.x, wid = __builtin_amdgcn_readfirstlane(tid >> 6), lane = tid & 63, wr = wid >> 2, wc = wid & 3, fr = lane & 15, fq = lane >> 4;
    const int K = g.K, nt = K / BK;
    unsigned voffA[2], voffB[2];
#pragma unroll
    for (int i = 0; i < 2; ++i) { int R, C; stage_rc(tid * 16 + i * 8192, R, C); const int Rb = Epi::PERM ? ((R & ~31) + perm32(R & 31)) : R;
        voffA[i] = (unsigned)(R * K + C) * 2u; voffB[i] = (unsigned)(Rb * K + C) * 2u; }
    const size_t kstep = (size_t)(BK * 2);
    const size_t hstep = (size_t)HALF * K * 2;
    const size_t tstep = 2 * hstep;
    const unsigned ldsw = (unsigned)wid * 1024u;
    const int aoff = lds_byte(wr * 64 + fr, fq * 8), boff = lds_byte(wc * 32 + fr, fq * 8);
#define PG8_SA(b, h) (((b) * 2 + (h)) * HTB)
#define PG8_SB(b, h) ((4 + (b) * 2 + (h)) * HTB)
#define PG8_STAGE(bufoff, gbase, voff) do { _Pragma("unroll") for (int _i = 0; _i < 2; ++_i) \
        __builtin_amdgcn_global_load_lds((const unsigned*)((const char*)(gbase) + (voff)[_i]), (PG8_LAS unsigned*)(lds + (bufoff) + ldsw + _i * 8192), 16, 0, 0); } while (0)
#define PG8_LDA(dst, b, h) do { _Pragma("unroll") for (int m = 0; m < 4; ++m) _Pragma("unroll") for (int k = 0; k < 2; ++k) dst[m][k] = *(const PG8_LAS bf16x8*)(lds + PG8_SA(b, h) + aoff + m * 2048 + k * 1024); } while (0)
#define PG8_LDB(dst, b, h) do { _Pragma("unroll") for (int n = 0; n < 2; ++n) _Pragma("unroll") for (int k = 0; k < 2; ++k) dst[n][k] = *(const PG8_LAS bf16x8*)(lds + PG8_SB(b, h) + boff + n * 2048 + k * 1024); } while (0)
#define PG8_MMA(ai, bj, At, Bt) do { __builtin_amdgcn_s_setprio(1); _Pragma("unroll") for (int m = 0; m < 4; ++m) _Pragma("unroll") for (int n = 0; n < 2; ++n) _Pragma("unroll") for (int k = 0; k < 2; ++k) \
        acc[ai][bj][m][n] = __builtin_amdgcn_mfma_f32_16x16x32_bf16(Bt[n][k], At[m][k], acc[ai][bj][m][n], 0, 0, 0); __builtin_amdgcn_s_setprio(0); } while (0)
#define PG8_WAIT_V(n) asm volatile("s_waitcnt vmcnt(" #n ")" ::: "memory")
#define PG8_WAIT_L(n) asm volatile("s_waitcnt lgkmcnt(" #n ")" ::: "memory")
#define PG8_BAR __builtin_amdgcn_s_barrier()
#define PG8_SCHED __builtin_amdgcn_sched_barrier(0)
    Unit cur, nxt; int ui = 0;
    if (!S.next(0, cur)) return;
    f32x4 acc[2][2][4][2];
#pragma unroll
    for (int a = 0; a < 2; ++a)
#pragma unroll
        for (int b = 0; b < 2; ++b)
#pragma unroll
            for (int m = 0; m < 4; ++m)
#pragma unroll
                for (int n = 0; n < 2; ++n) acc[a][b][m][n] = (f32x4){0.f, 0.f, 0.f, 0.f};
    bf16x8 At[4][2], B0[2][2], B1[2][2];
    const char* cA = (const char*)g.A + (size_t)cur.pm * tstep; const char* cB = (const char*)g.Bt + (size_t)cur.pn * tstep;
    S.a_ready(cur);
    if constexpr (SP2) {
        PG8_STAGE(PG8_SB(0, 0), cB, voffB); PG8_STAGE(PG8_SB(0, 1), cB + hstep, voffB); PG8_STAGE(PG8_SA(0, 0), cA, voffA); PG8_STAGE(PG8_SA(0, 1), cA + hstep, voffA);
        if (wr == 1) PG8_BAR;
        PG8_WAIT_V(2); PG8_BAR;
        PG8_STAGE(PG8_SB(1, 0), cB + kstep, voffB); PG8_STAGE(PG8_SA(1, 0), cA + kstep, voffA); PG8_STAGE(PG8_SB(1, 1), cB + hstep + kstep, voffB);
        PG8_WAIT_V(6); PG8_BAR;
    } else {
        PG8_STAGE(PG8_SB(0, 0), cB, voffB); PG8_STAGE(PG8_SA(0, 0), cA, voffA); PG8_STAGE(PG8_SB(0, 1), cB + hstep, voffB); PG8_STAGE(PG8_SA(0, 1), cA + hstep, voffA);
        if (wr == 1) PG8_BAR;
        PG8_WAIT_V(4); PG8_BAR;
        PG8_STAGE(PG8_SB(1, 0), cB + kstep, voffB); PG8_STAGE(PG8_SA(1, 0), cA + kstep, voffA); PG8_STAGE(PG8_SB(1, 1), cB + hstep + kstep, voffB);
        PG8_WAIT_V(6); PG8_BAR;
    }
    for (;;) {
        const bool has_next = S.next(ui + 1, nxt);
        const char* nA = has_next ? (const char*)g.A + (size_t)nxt.pm * tstep : cA; const char* nB = has_next ? (const char*)g.Bt + (size_t)nxt.pn * tstep : cB;
        for (int t = 0; t < nt; t += 2) {
            const bool last = (t == nt - 2);
            const char* a1 = cA + (size_t)(t + 1) * kstep;
            const char* a2 = last ? nA : cA + (size_t)(t + 2) * kstep; const char* b2 = last ? nB : cB + (size_t)(t + 2) * kstep;
            const char* a3 = a2 + kstep; const char* b3 = b2 + kstep;
            if (last && has_next) S.a_ready(nxt);
            if constexpr (SP2) {
            PG8_LDB(B0, 0, 0); PG8_LDB(B1, 0, 1); PG8_SCHED; PG8_LDA(At, 0, 0); PG8_STAGE(PG8_SA(1, 1), a1 + hstep, voffA);
            PG8_WAIT_V(8); PG8_WAIT_L(0); PG8_BAR; PG8_MMA(0, 0, At, B0); PG8_MMA(0, 1, At, B1); PG8_BAR; PG8_SCHED;
            PG8_LDA(At, 0, 1); PG8_STAGE(PG8_SB(0, 0), b2, voffB); PG8_STAGE(PG8_SB(0, 1), b2 + hstep, voffB); PG8_STAGE(PG8_SA(0, 0), a2, voffA);
            PG8_WAIT_V(8); PG8_WAIT_L(0); PG8_BAR; PG8_MMA(1, 0, At, B0); PG8_MMA(1, 1, At, B1); PG8_BAR; PG8_SCHED;
            PG8_LDB(B0, 1, 0); PG8_LDB(B1, 1, 1); PG8_SCHED; PG8_LDA(At, 1, 0); PG8_STAGE(PG8_SA(0, 1), a2 + hstep, voffA);
            PG8_WAIT_V(8); PG8_WAIT_L(0); PG8_BAR; PG8_MMA(0, 0, At, B0); PG8_MMA(0, 1, At, B1); PG8_BAR; PG8_SCHED;
            PG8_LDA(At, 1, 1); PG8_STAGE(PG8_SB(1, 0), b3, voffB); PG8_STAGE(PG8_SB(1, 1), b3 + hstep, voffB); PG8_STAGE(PG8_SA(1, 0), a3, voffA);
            PG8_WAIT_V(8); PG8_WAIT_L(0); PG8_BAR; PG8_MMA(1, 0, At, B0); PG8_MMA(1, 1, At, B1); PG8_BAR; PG8_SCHED;
            } else {
            PG8_LDB(B0, 0, 0); PG8_SCHED; PG8_LDA(At, 0, 0); PG8_STAGE(PG8_SA(1, 1), a1 + hstep, voffA);
            PG8_WAIT_L(8); PG8_BAR; PG8_WAIT_L(0); PG8_MMA(0, 0, At, B0); PG8_BAR; PG8_SCHED;
            PG8_LDB(B1, 0, 1); PG8_STAGE(PG8_SB(0, 0), b2, voffB);
            PG8_BAR; PG8_WAIT_L(0); PG8_MMA(0, 1, At, B1); PG8_BAR;
            PG8_LDA(At, 0, 1); PG8_STAGE(PG8_SA(0, 0), a2, voffA);
            PG8_BAR; PG8_WAIT_L(0); PG8_MMA(1, 0, At, B0); PG8_BAR; PG8_SCHED;
            PG8_STAGE(PG8_SB(0, 1), b2 + hstep, voffB);
            PG8_WAIT_V(6); PG8_BAR; PG8_MMA(1, 1, At, B1); PG8_BAR;
            PG8_LDB(B0, 1, 0); PG8_SCHED; PG8_LDA(At, 1, 0); PG8_STAGE(PG8_SA(0, 1), a2 + hstep, voffA);
            PG8_WAIT_L(8); PG8_BAR; PG8_WAIT_L(0); PG8_MMA(0, 0, At, B0); PG8_BAR; PG8_SCHED;
            PG8_LDB(B1, 1, 1); PG8_STAGE(PG8_SB(1, 0), b3, voffB);
            PG8_BAR; PG8_WAIT_L(0); PG8_MMA(0, 1, At, B1); PG8_BAR;
            PG8_LDA(At, 1, 1); PG8_STAGE(PG8_SA(1, 0), a3, voffA);
            PG8_BAR; PG8_WAIT_L(0); PG8_MMA(1, 0, At, B0); PG8_BAR; PG8_SCHED;
            PG8_STAGE(PG8_SB(1, 1), b3 + hstep, voffB);
            PG8_WAIT_V(6); PG8_BAR; PG8_MMA(1, 1, At, B1); PG8_BAR;
            }
        }
        if constexpr (ALIGN_EPI) { if (wr == 0) PG8_BAR; }
        if constexpr (!Epi::AFTER_DRAIN) { E(acc, cur, wr, wc, fr, fq); S.done(cur); }
        if (!has_next) break;
#pragma unroll
        for (int a = 0; a < 2; ++a)
#pragma unroll
            for (int b = 0; b < 2; ++b)
#pragma unroll
                for (int m = 0; m < 4; ++m)
#pragma unroll
                    for (int n = 0; n < 2; ++n) acc[a][b][m][n] = (f32x4){0.f, 0.f, 0.f, 0.f};
        cur = nxt; cA = nA; cB = nB; ++ui;
        if constexpr (ALIGN_EPI) { if (wr == 1) PG8_BAR; }
    }
    PG8_WAIT_V(0);
    if constexpr (!ALIGN_EPI) { if (wr == 0) PG8_BAR; }
    PG8_BAR;
    if constexpr (Epi::AFTER_DRAIN) { E.fused(acc, cur, wr, wc, fr, fq, lds, wid, lane); S.done(cur); }
#undef PG8_SA
#undef PG8_SB
#undef PG8_STAGE
#undef PG8_LDA
#undef PG8_LDB
#undef PG8_MMA
#undef PG8_WAIT_V
#undef PG8_WAIT_L
#undef PG8_BAR
#undef PG8_SCHED
}
}

constexpr int NWAVES = 8, NTHR = NWAVES * 64;
constexpr int M = 65536, SEQ = 4096, D = 1024, INC = 2560, FF = 4096, NMEM = 256, MROWS = 4096  ;
constexpr float EPS = 1e-6f;
constexpr int NPHASE = 10;
#ifndef MK_N_LAUNCHES
#define MK_N_LAUNCHES 1
#endif
constexpr size_t MiB = 1u << 20;
constexpr size_t WS_RSTD0 = 1 * MiB, WS_RSTDM = 2 * MiB, WS_PWT = 3 * MiB;
constexpr size_t WS_SS1 = 768 * MiB, WS_SS2 = 772 * MiB, WS_SS3 = 776 * MiB;
constexpr size_t WS_WIN = 4 * MiB, WS_WOUT = 9 * MiB, WS_WQ = 11 * MiB, WS_WKV = 13 * MiB, WS_WO = 17 * MiB, WS_WUP = 19 * MiB, WS_WDN = 27 * MiB;
constexpr size_t WS_KB = 36 * MiB, WS_VT = 44 * MiB, WS_MEMB = 52 * MiB;
constexpr size_t WS_BUFA = 64 * MiB;
constexpr size_t WS_U = 192 * MiB;
constexpr size_t WS_LF = 512 * MiB;
constexpr size_t WS_YMIX = 640 * MiB;
constexpr size_t WS_QX = 192 * MiB, WS_OB = 320 * MiB;
constexpr size_t WS_A2 = 192 * MiB;
constexpr size_t WS_SL = 784 * MiB, WS_DL = 800 * MiB;
constexpr size_t WS_END = 801 * MiB;
constexpr int LDS_BYTES = 147456;

typedef unsigned short bf16;
typedef unsigned u32x4 __attribute__((ext_vector_type(4)));
typedef unsigned u32x2 __attribute__((ext_vector_type(2)));
typedef float f32x4 __attribute__((ext_vector_type(4)));
typedef short bf16x8 __attribute__((ext_vector_type(8)));
#define MFMA16(a, b, c) __builtin_amdgcn_mfma_f32_16x16x32_bf16((a), (b), (c), 0, 0, 0)
__device__ __forceinline__ f32x4 mfma_safe(bf16x8 a, bf16x8 b, f32x4 c) { f32x4 d = MFMA16(a, b, c); asm volatile("" : "+v"(d) : "v"(a), "v"(b)); return d; }
__device__ __forceinline__ float bflo(unsigned w) { return __uint_as_float(w << 16); }
__device__ __forceinline__ float bfhi(unsigned w) { return __uint_as_float(w & 0xffff0000u); }
__device__ __forceinline__ unsigned pk2(float lo, float hi) { return pg8::cvt_pk_bf16(lo, hi); }
__device__ __forceinline__ float wave_sum(float v) {
#pragma unroll
    for (int o = 1; o < 64; o <<= 1) v += __shfl_xor(v, o);
    return v;
}
#define LDS_FENCE() asm volatile("s_waitcnt lgkmcnt(0)" ::: "memory")
__device__ __forceinline__ f32x4 zero_acc() { f32x4 z = {0.f, 0.f, 0.f, 0.f}; asm volatile("" : "+v"(z)); return z; }

__device__ __forceinline__ void p0_transpose_item(const float* W, int K, int N, const float* gain, bf16* WT, float* scr, int item, int lane) {
    const int nblk = N / 32, kb = item / nblk, nb = item % nblk, k0 = 64 * kb, n0 = 32 * nb;
#pragma unroll 8
    for (int i = 0; i < 32; ++i) { const int kk = 2 * i + (lane >> 5); const float g = gain ? gain[k0 + kk] : 1.0f; scr[kk * 33 + (lane & 31)] = W[(size_t)(k0 + kk) * N + n0 + (lane & 31)] * g; }
    LDS_FENCE();
    const int c = lane & 7;
#pragma unroll
    for (int j = 0; j < 4; ++j) { const int n = (lane >> 3) + 8 * j; const float* s = scr + (8 * c) * 33 + n;
        u32x4 o; o.x = pk2(s[0 * 33], s[1 * 33]); o.y = pk2(s[2 * 33], s[3 * 33]); o.z = pk2(s[4 * 33], s[5 * 33]); o.w = pk2(s[6 * 33], s[7 * 33]);
        *(u32x4*)(WT + (size_t)(n0 + n) * K + k0 + 8 * c) = o; }
    LDS_FENCE();
}
__device__ __forceinline__ void p0_row(const float* xrow, bf16* orow, float* rstd_out, int lane) {
    const f32x4* xr = (const f32x4*)xrow + lane;
    f32x4 v[4]; float s = 0.f;
#pragma unroll
    for (int j = 0; j < 4; ++j) { v[j] = xr[64 * j]; s += (v[j][0] * v[j][0] + v[j][1] * v[j][1]) + (v[j][2] * v[j][2] + v[j][3] * v[j][3]); }
    s = wave_sum(s);
    u32x2* o8 = (u32x2*)orow + lane;
#pragma unroll
    for (int j = 0; j < 4; ++j) { u32x2 w; w.x = pk2(v[j][0], v[j][1]); w.y = pk2(v[j][2], v[j][3]); o8[64 * j] = w; }
    if (lane == 0) *rstd_out = rsqrtf(s * (1.0f / D) + EPS);
}

template <int G> __device__ __forceinline__ void pool_wave_unit(int tb, const bf16* U, bf16* Y, int lane) {
    constexpr int W = 2 << G;
    const int fr = lane & 15, fq = lane >> 4;
    const int row = tb * 16 + fr, t = row & (SEQ - 1);
    const int nwin = (t + 1 < W) ? (t + 1) : W; const float inv = 1.0f / (float)nwin;
    bf16x8 pf[4];
#pragma unroll
    for (int ks = 0; ks < 4; ++ks) {
        const bf16* p = U + (size_t)row * 512 + G * 128 + ks * 32 + 8 * fq;
        float a[8];
#pragma unroll
        for (int j = 0; j < 8; ++j) a[j] = 0.f;
        u32x4 cur = *(const u32x4*)p;
#pragma unroll
        for (int s = 0; s < W; ++s) { u32x4 v = *(const u32x4*)(p - (size_t)((s < nwin) ? s : 0) * 512);
            if (s >= nwin) v = (u32x4){0u, 0u, 0u, 0u};
#pragma unroll
            for (int e = 0; e < 4; ++e) { a[2 * e] += bflo(v[e]); a[2 * e + 1] += bfhi(v[e]); } }
        u32x4 o;
#pragma unroll
        for (int e = 0; e < 4; ++e) o[e] = pk2(a[2 * e] * inv - bflo(cur[e]), a[2 * e + 1] * inv - bfhi(cur[e]));
        pf[ks] = __builtin_bit_cast(bf16x8, o);
    }
#pragma unroll
    for (int ks = 0; ks < 4; ++ks) *(bf16x8*)(Y + (size_t)row * D + G * 128 + ks * 32 + 8 * fq) = pf[ks];
}

constexpr int H_QR = 0, H_KR = 17408, H_QG = 34816, H_KET = 52224, H_VT = 70656, H_P = 89088, H_O = 98304, H_WT = 132096, H_DEC = 136192;
static_assert(H_DEC + 512 <= LDS_BYTES, "hgrn LDS map");
template <bool STATE_ONLY>
__device__ __forceinline__ void hgrn_unit(unsigned char* lds, int b, int h, int seg, const bf16* U, const float* LF, const float* gnorm, bf16* Y, float* SL, float* DL) {
#define HG_BAR() do { asm volatile("s_waitcnt lgkmcnt(0)" ::: "memory"); __builtin_amdgcn_s_barrier(); asm volatile("" ::: "memory"); } while (0)
    const int tid = threadIdx.x, lane = tid & 63, w = tid >> 6, fr = lane & 15, fq = lane >> 4;
    const int dkg = tid & 15, tp = tid >> 4, dk0 = 8 * dkg, t0 = 2 * tp;
    bf16* Qr = (bf16*)(lds + H_QR); bf16* Kr = (bf16*)(lds + H_KR); bf16* Qg = (bf16*)(lds + H_QG); bf16* KeT = (bf16*)(lds + H_KET); bf16* Vt = (bf16*)(lds + H_VT); bf16* P = (bf16*)(lds + H_P);
    float* O = (float*)(lds + H_O); float* WT = (float*)(lds + H_WT); float* DEC = (float*)(lds + H_DEC);
    f32x4 S[8];
#pragma unroll
    for (int i = 0; i < 8; ++i) S[i] = (f32x4){0.f, 0.f, 0.f, 0.f};
    const int bh = b * 4 + h, c0 = seg * 16, c1 = c0 + 16;
    if constexpr (!STATE_ONLY) {
        for (int js = 0; js < seg; ++js)
#pragma unroll
            for (int i = 0; i < 8; ++i) { const f32x4 dl = *(const f32x4*)(DL + (size_t)(bh * 4 + js) * 128 + 16 * i + 4 * fq); const f32x4 sl = *(const f32x4*)(SL + ((size_t)((bh * 4 + js) * 8 + i) * NTHR + tid) * 4);
                S[i] = S[i] * (f32x4){__expf(dl[0]), __expf(dl[1]), __expf(dl[2]), __expf(dl[3])} + sl; }
    }
    float gsum[8];
#pragma unroll
    for (int j = 0; j < 8; ++j) gsum[j] = 0.f;
    constexpr size_t HSTR = (size_t)64 * 4096 * 128;
    u32x4 rq[2], rk[2], rv[2], rg[2]; f32x4 rl[2][2];
#define HG_LOAD(c) do { _Pragma("unroll") for (int tt = 0; tt < 2; ++tt) { const size_t o_ = ((size_t)bh * SEQ + (size_t)(c) * 64 + t0 + tt) * 128 + dk0; \
        if (!STATE_ONLY) rq[tt] = *(const u32x4*)(U + o_); rk[tt] = *(const u32x4*)(U + HSTR + o_); rv[tt] = *(const u32x4*)(U + 2 * HSTR + o_); \
        const float* lp = LF + o_; rl[tt][0] = *(const f32x4*)lp; rl[tt][1] = *(const f32x4*)(lp + 4); } } while (0)
#define HG_LOADG(c) do { _Pragma("unroll") for (int tt = 0; tt < 2; ++tt) { const size_t o_ = ((size_t)bh * SEQ + (size_t)(c) * 64 + t0 + tt) * 128 + dk0; rg[tt] = *(const u32x4*)(U + 3 * HSTR + o_); } } while (0)
    HG_LOAD(c0);
    for (int c = c0; c < c1; ++c) {
        float a[8], bs[8];
#pragma unroll
        for (int j = 0; j < 8; ++j) { a[j] = rl[0][j >> 2][j & 3]; bs[j] = a[j] + rl[1][j >> 2][j & 3]; }
        float x[8];
#pragma unroll
        for (int j = 0; j < 8; ++j) { x[j] = bs[j]; float y = __shfl_up(x[j], 16); if (lane >= 16) x[j] += y; y = __shfl_up(x[j], 32); if (lane >= 32) x[j] += y; }
        if (lane >= 48) { *(f32x4*)(WT + w * 128 + dk0) = (f32x4){x[0], x[1], x[2], x[3]}; *(f32x4*)(WT + w * 128 + dk0 + 4) = (f32x4){x[4], x[5], x[6], x[7]}; }
        HG_BAR();
        float base[8], gmid[8], glast[8];
#pragma unroll
        for (int j = 0; j < 8; ++j) { base[j] = 0.f; gmid[j] = 0.f; glast[j] = 0.f; }
#pragma unroll
        for (int w2 = 0; w2 < 8; ++w2) { const f32x4 v0 = *(const f32x4*)(WT + w2 * 128 + dk0), v1 = *(const f32x4*)(WT + w2 * 128 + dk0 + 4);
#pragma unroll
            for (int j = 0; j < 8; ++j) { const float tv = (j < 4) ? v0[j & 3] : v1[j & 3]; if (w2 < w) base[j] += tv; if (w2 < 4) gmid[j] += tv; glast[j] += tv; } }
        float ke[2][8];
        {
            float emid[8], elm[8];
#pragma unroll
            for (int j = 0; j < 8; ++j) { emid[j] = __expf(gmid[j]); elm[j] = __expf(glast[j] - gmid[j]); base[j] += x[j] - bs[j]; if (STATE_ONLY) gsum[j] += glast[j]; }
            if (tp == 0) { *(f32x4*)(DEC + dk0) = (f32x4){emid[0] * elm[0], emid[1] * elm[1], emid[2] * elm[2], emid[3] * elm[3]}; *(f32x4*)(DEC + dk0 + 4) = (f32x4){emid[4] * elm[4], emid[5] * elm[5], emid[6] * elm[6], emid[7] * elm[7]}; }
#pragma unroll
            for (int tt = 0; tt < 2; ++tt) { float qr[8], kr[8], qg[8];
#pragma unroll
                for (int j = 0; j < 8; ++j) { const float Gv = base[j] + (tt ? bs[j] : a[j]);
                    const float e1 = __expf(Gv - gmid[j]), e2 = __builtin_amdgcn_rcpf(e1);
                    const unsigned qw = STATE_ONLY ? 0u : rq[tt][j >> 1], kw = rk[tt][j >> 1];
                    const float q = (j & 1) ? bfhi(qw) : bflo(qw), k = (j & 1) ? bfhi(kw) : bflo(kw);
                    qr[j] = q * e1; kr[j] = k * e2; ke[tt][j] = kr[j] * elm[j]; qg[j] = qr[j] * emid[j]; }
                if constexpr (!STATE_ONLY) { const int t = t0 + tt;
                *(u32x4*)(Qr + t * 136 + dk0) = (u32x4){pk2(qr[0], qr[1]), pk2(qr[2], qr[3]), pk2(qr[4], qr[5]), pk2(qr[6], qr[7])};
                *(u32x4*)(Kr + t * 136 + dk0) = (u32x4){pk2(kr[0], kr[1]), pk2(kr[2], kr[3]), pk2(kr[4], kr[5]), pk2(kr[6], kr[7])};
                *(u32x4*)(Qg + t * 136 + dk0) = (u32x4){pk2(qg[0], qg[1]), pk2(qg[2], qg[3]), pk2(qg[4], qg[5]), pk2(qg[6], qg[7])}; }
                __builtin_amdgcn_sched_barrier(0); }
        }
#pragma unroll
        for (int j = 0; j < 8; ++j) { const int tsw = ((((t0 >> 3) ^ (dkg & 7)) << 3) | (t0 & 7));
            *(unsigned*)(KeT + (dk0 + j) * 72 + tsw) = pk2(ke[0][j], ke[1][j]);
            const unsigned v0 = rv[0][j >> 1], v1 = rv[1][j >> 1];
            *(unsigned*)(Vt + (dk0 + j) * 72 + tsw) = (j & 1) ? ((v0 >> 16) | (v1 & 0xffff0000u)) : ((v0 & 0xffffu) | (v1 << 16)); }
        HG_BAR();
        if constexpr (!STATE_ONLY) HG_LOADG(c);
        if (c + 1 < c1) HG_LOAD(c + 1);
        if constexpr (!STATE_ONLY) { const int ti = w >> 1;
#pragma unroll
          for (int s2 = 0; s2 < 2; ++s2) { const int si = 2 * (w & 1) + s2; u32x2 pw; pw.x = 0u; pw.y = 0u;
              if (si <= ti) { f32x4 sc = zero_acc();
#pragma unroll
                  for (int ks = 0; ks < 4; ++ks) { const bf16x8 kf = *(const bf16x8*)(Kr + (si * 16 + fr) * 136 + ks * 32 + 8 * fq), qf = *(const bf16x8*)(Qr + (ti * 16 + fr) * 136 + ks * 32 + 8 * fq); sc = mfma_safe(kf, qf, sc); }
                  const int tix = ti * 16 + fr, six = si * 16 + 4 * fq;
#pragma unroll
                  for (int i = 0; i < 4; ++i) if (six + i > tix) sc[i] = 0.f;
                  pw.x = pk2(sc[0], sc[1]); pw.y = pk2(sc[2], sc[3]); }
              *(u32x2*)(P + (ti * 16 + fr) * 72 + si * 16 + 4 * fq) = pw; } }
        f32x4 ao[4];
        if constexpr (!STATE_ONLY) { bf16x8 Sb[4];
#pragma unroll
          for (int kk = 0; kk < 4; ++kk) { u32x4 o; o.x = pk2(S[2 * kk][0], S[2 * kk][1]); o.y = pk2(S[2 * kk][2], S[2 * kk][3]); o.z = pk2(S[2 * kk + 1][0], S[2 * kk + 1][1]); o.w = pk2(S[2 * kk + 1][2], S[2 * kk + 1][3]); Sb[kk] = __builtin_bit_cast(bf16x8, o); }
#pragma unroll
          for (int tt = 0; tt < 4; ++tt) { ao[tt] = zero_acc();
#pragma unroll
              for (int kk = 0; kk < 4; ++kk) { const bf16* qp = Qg + (tt * 16 + fr) * 136 + 32 * kk + 4 * fq; const u32x2 lo = *(const u32x2*)qp, hi = *(const u32x2*)(qp + 16);
                  const u32x4 af = {lo.x, lo.y, hi.x, hi.y}; ao[tt] = mfma_safe(__builtin_bit_cast(bf16x8, af), Sb[kk], ao[tt]); } } }
        bf16x8 Vf[2];
#pragma unroll
        for (int ks = 0; ks < 2; ++ks) Vf[ks] = *(const bf16x8*)(Vt + (16 * w + fr) * 72 + (((ks * 4 + fq) ^ ((2 * w + (fr >> 3)) & 7)) << 3));
#pragma unroll
        for (int i = 0; i < 8; ++i) { const f32x4 dc = *(const f32x4*)(DEC + 16 * i + 4 * fq); S[i] = S[i] * dc;
#pragma unroll
            for (int ks = 0; ks < 2; ++ks) { const bf16x8 kf = *(const bf16x8*)(KeT + (16 * i + fr) * 72 + (((ks * 4 + fq) ^ ((2 * i + (fr >> 3)) & 7)) << 3)); S[i] = mfma_safe(kf, Vf[ks], S[i]); } }
        if constexpr (!STATE_ONLY) {
        HG_BAR();
#pragma unroll
        for (int tt = 0; tt < 4; ++tt)
#pragma unroll
            for (int ks = 0; ks < 2; ++ks) { const bf16x8 pf = *(const bf16x8*)(P + (tt * 16 + fr) * 72 + ks * 32 + 8 * fq); ao[tt] = mfma_safe(pf, Vf[ks], ao[tt]); }
#pragma unroll
        for (int tt = 0; tt < 4; ++tt)
#pragma unroll
            for (int i = 0; i < 4; ++i) O[(tt * 16 + 4 * fq + i) * 132 + 16 * w + fr] = ao[tt][i];
        HG_BAR();
        f32x4 gn[2]; gn[0] = *(const f32x4*)(gnorm + h * 128 + dk0); gn[1] = *(const f32x4*)(gnorm + h * 128 + dk0 + 4);
#pragma unroll
        for (int tt = 0; tt < 2; ++tt) { const int t = t0 + tt; const f32x4 o0 = *(const f32x4*)(O + t * 132 + dk0), o1 = *(const f32x4*)(O + t * 132 + dk0 + 4);
            float ssq = (o0[0] * o0[0] + o0[1] * o0[1]) + (o0[2] * o0[2] + o0[3] * o0[3]) + (o1[0] * o1[0] + o1[1] * o1[1]) + (o1[2] * o1[2] + o1[3] * o1[3]);
            ssq += __shfl_xor(ssq, 1); ssq += __shfl_xor(ssq, 2); ssq += __shfl_xor(ssq, 4); ssq += __shfl_xor(ssq, 8);
            const float rs = rsqrtf(ssq * (1.0f / 128.0f) + EPS);
            u32x4 ow;
#pragma unroll
            for (int e = 0; e < 4; ++e) { const unsigned gw = rg[tt][e]; const float oa = (e < 2) ? o0[2 * e] : o1[2 * e - 4], ob = (e < 2) ? o0[2 * e + 1] : o1[2 * e - 3];
                const float ga = (e < 2) ? gn[0][2 * e] : gn[1][2 * e - 4], gb = (e < 2) ? gn[0][2 * e + 1] : gn[1][2 * e - 3];
                ow[e] = pk2(oa * rs * ga * bflo(gw), ob * rs * gb * bfhi(gw)); }
            *(u32x4*)(Y + ((size_t)b * SEQ + (size_t)c * 64 + t) * D + 512 + h * 128 + dk0) = ow; }
        }
    }
    if constexpr (STATE_ONLY) {
#pragma unroll
        for (int i = 0; i < 8; ++i) *(f32x4*)(SL + ((size_t)((bh * 4 + seg) * 8 + i) * NTHR + tid) * 4) = S[i];
        if (tp == 0) { *(f32x4*)(DL + (size_t)(bh * 4 + seg) * 128 + dk0) = (f32x4){gsum[0], gsum[1], gsum[2], gsum[3]}; *(f32x4*)(DL + (size_t)(bh * 4 + seg) * 128 + dk0 + 4) = (f32x4){gsum[4], gsum[5], gsum[6], gsum[7]}; }
    }
#undef HG_LOAD
#undef HG_LOADG
#undef HG_BAR
}

constexpr int AT_QS = 0, AT_PS = 67584, AT_MX = 135168, AT_LS = AT_MX + 4096;
static_assert(AT_LS + 4096 <= LDS_BYTES - 16, "attention LDS map");
__device__ __forceinline__ void attn_wg(unsigned char* lds, int bx, const bf16* Q, const bf16* Kb, const bf16* Vt, bf16* Ob) {
    const int tid = threadIdx.x, lane = tid & 63, w = tid >> 6, fr = lane & 15, fq = lane >> 4;
    const int bh = bx >> 2, b = bh >> 2, h = bh & 3;
    const size_t rowbase = (size_t)b * SEQ + (size_t)(bx & 3) * 1024;
    unsigned char* Qs = lds + AT_QS; unsigned char* Ps = lds + AT_PS; float* MX = (float*)(lds + AT_MX); float* LS = (float*)(lds + AT_LS);
#define AT_BAR() do { asm volatile("s_waitcnt lgkmcnt(0)" ::: "memory"); __builtin_amdgcn_s_barrier(); asm volatile("" ::: "memory"); } while (0)
    bf16x8 Kf[2][8], Vf[2][8];
#pragma unroll
    for (int t = 0; t < 2; ++t)
#pragma unroll
        for (int ks = 0; ks < 8; ++ks) { Kf[t][ks] = *(const bf16x8*)(Kb + (size_t)(b * NMEM + 32 * w + 16 * t + fr) * D + h * 256 + ks * 32 + 8 * fq);
                                         Vf[t][ks] = *(const bf16x8*)(Vt + (size_t)(h * 256 + 32 * w + 16 * t + fr) * MROWS + b * NMEM + ks * 32 + 8 * fq); }
    u32x4 qs[4];
#define AT_QLOAD(uu) do { const char* qb_ = (const char*)(Q + (rowbase + (size_t)(uu) * 64) * D + h * 256); unsigned qoff = (unsigned)(((tid >> 5) * D + (tid & 31) * 8) * 2); \
        _Pragma("unroll") for (int i = 0; i < 4; ++i) { qs[i] = *(const u32x4*)(qb_ + qoff); qoff += 16 * D * 2; asm volatile("" : "+v"(qoff)); } } while (0)
#define AT_QSTORE() do { _Pragma("unroll") for (int i = 0; i < 4; ++i) { const int p_ = tid + NTHR * i; *(u32x4*)(Qs + (p_ >> 5) * 528 + (p_ & 31) * 16) = qs[i]; } } while (0)
    AT_QLOAD(0); AT_QSTORE(); AT_BAR();
    for (int u = 0; u < 16; ++u) {
        const size_t row0 = rowbase + (size_t)u * 64;
        char* ob_u = (char*)(Ob + row0 * D + h * 256);
        AT_QLOAD(u + 1);
        f32x4 S[2][4];
#pragma unroll
        for (int t = 0; t < 2; ++t)
#pragma unroll
            for (int rt = 0; rt < 4; ++rt) S[t][rt] = zero_acc();
#pragma unroll
        for (int rt = 0; rt < 4; ++rt)
#pragma unroll
            for (int k0 = 0; k0 < 8; k0 += 4) { bf16x8 qf[4];
#pragma unroll
                for (int k = 0; k < 4; ++k) qf[k] = *(const bf16x8*)(Qs + (rt * 16 + fr) * 528 + ((k0 + k) * 32 + 8 * fq) * 2);
                __builtin_amdgcn_sched_barrier(0);
#pragma unroll
                for (int k = 0; k < 4; ++k) { S[0][rt] = MFMA16(Kf[0][k0 + k], qf[k], S[0][rt]); S[1][rt] = MFMA16(Kf[1][k0 + k], qf[k], S[1][rt]); }
                __builtin_amdgcn_sched_barrier(0); }
#pragma unroll
        for (int rt = 0; rt < 4; ++rt) { float m = fmaxf(fmaxf(fmaxf(S[0][rt][0], S[0][rt][1]), fmaxf(S[0][rt][2], S[0][rt][3])), fmaxf(fmaxf(S[1][rt][0], S[1][rt][1]), fmaxf(S[1][rt][2], S[1][rt][3])));
            m = fmaxf(m, __shfl_xor(m, 16)); m = fmaxf(m, __shfl_xor(m, 32));
            if (fq == 0) MX[w * 64 + rt * 16 + fr] = m;
            __builtin_amdgcn_sched_barrier(0); }
        AT_BAR();
#pragma unroll
        for (int rt = 0; rt < 4; ++rt) { float gm = MX[rt * 16 + fr];
#pragma unroll
            for (int w2 = 1; w2 < 8; ++w2) gm = fmaxf(gm, MX[w2 * 64 + rt * 16 + fr]);
            float l = 0.f;
#pragma unroll
            for (int t = 0; t < 2; ++t) {
#pragma unroll
                for (int i = 0; i < 4; ++i) { const float p = __builtin_amdgcn_exp2f(S[t][rt][i] - gm); S[t][rt][i] = p; l += p; }
                u32x2 o; o.x = pk2(S[t][rt][0], S[t][rt][1]); o.y = pk2(S[t][rt][2], S[t][rt][3]);
                *(u32x2*)(Ps + (rt * 16 + fr) * 528 + (32 * w + 16 * t + 4 * fq) * 2) = o; }
            l += __shfl_xor(l, 16); l += __shfl_xor(l, 32);
            if (fq == 0) LS[w * 64 + rt * 16 + fr] = l;
            __builtin_amdgcn_sched_barrier(0); }
        AT_BAR();
        AT_QSTORE();
        f32x4 Oa[2][4];
#pragma unroll
        for (int t = 0; t < 2; ++t)
#pragma unroll
            for (int rt = 0; rt < 4; ++rt) Oa[t][rt] = zero_acc();
#pragma unroll
        for (int rt = 0; rt < 4; ++rt)
#pragma unroll
            for (int k0 = 0; k0 < 8; k0 += 4) { bf16x8 pf[4];
#pragma unroll
                for (int k = 0; k < 4; ++k) pf[k] = *(const bf16x8*)(Ps + (rt * 16 + fr) * 528 + ((k0 + k) * 32 + 8 * fq) * 2);
                __builtin_amdgcn_sched_barrier(0);
#pragma unroll
                for (int k = 0; k < 4; ++k) { Oa[0][rt] = MFMA16(Vf[0][k0 + k], pf[k], Oa[0][rt]); Oa[1][rt] = MFMA16(Vf[1][k0 + k], pf[k], Oa[1][rt]); }
                __builtin_amdgcn_sched_barrier(0); }
        unsigned ooff = (unsigned)((fr * D + 32 * w + 4 * fq) * 2);
#pragma unroll
        for (int rt = 0; rt < 4; ++rt) { float l = LS[rt * 16 + fr];
#pragma unroll
            for (int w2 = 1; w2 < 8; ++w2) l += LS[w2 * 64 + rt * 16 + fr];
            const float inv = 1.0f / l;
#pragma unroll
            for (int t = 0; t < 2; ++t) { u32x2 o; o.x = pk2(Oa[t][rt][0] * inv, Oa[t][rt][1] * inv); o.y = pk2(Oa[t][rt][2] * inv, Oa[t][rt][3] * inv);
                *(u32x2*)(ob_u + ooff + t * 32) = o; }
            ooff += 16 * D * 2; asm volatile("" : "+v"(ooff));
            __builtin_amdgcn_sched_barrier(0); }
        AT_BAR();
    }
#undef AT_BAR
#undef AT_QLOAD
#undef AT_QSTORE
}

#define LAS __attribute__((address_space(3)))
#define XB_TMO      128
#define XB_XCNT(j)  (256  + 64 * (j))
#define XB_XSUB(j)  (1280 + 64 * (j))
#define XB_XGEN(j)  (2304 + 64 * (j))
#define XB_TOP      3328
#define XB_TOPGEN   3392
#define XCD_BAR_WORDS 3456
#define XB_SPIN_CAP (1u << 18)

__device__ __forceinline__ unsigned xb_ld(unsigned* p)              { return __hip_atomic_load(p, __ATOMIC_RELAXED, __HIP_MEMORY_SCOPE_AGENT); }
__device__ __forceinline__ unsigned xb_add(unsigned* p, unsigned v) { return __hip_atomic_fetch_add(p, v, __ATOMIC_RELAXED, __HIP_MEMORY_SCOPE_AGENT); }
__device__ __forceinline__ unsigned xb_xcc_id() { return (unsigned)__builtin_amdgcn_s_getreg((3 << 11) | 20) & 0xFu; }
#define XB_SPIN(cond, bar) do { unsigned _sp = 0; while (cond) { __builtin_amdgcn_s_sleep(1); \
    if ((++_sp & 255u) == 0u) { if (xb_ld(&(bar)[XB_TMO])) break; if (_sp > XB_SPIN_CAP) { atomicAdd(&(bar)[XB_TMO], 1u); break; } } } } while (0)

struct XcdBarrier {
    unsigned* bar; unsigned x;
    volatile LAS unsigned* st;
};

__device__ __forceinline__ XcdBarrier xcd_barrier_post(unsigned* bar, volatile LAS unsigned* st) {
    XcdBarrier b; b.bar = bar; b.x = xb_xcc_id(); b.st = st;
    if (threadIdx.x == 0) (void)xb_add(&bar[XB_XCNT(b.x)], 1u);
    return b;
}
__device__ __forceinline__ void xcd_barrier_complete(unsigned* bar, unsigned x, unsigned& nloc, unsigned& nx) {
    const unsigned G = gridDim.x * gridDim.y * gridDim.z;
    unsigned sum, cnt, mine, sp = 0u;
    for (;;) {
        sum = 0u; cnt = 0u; mine = 0u;
#pragma unroll
        for (unsigned j = 0; j < 16; ++j) { const unsigned c = xb_ld(&bar[XB_XCNT(j)]); sum += c; cnt += (c > 0u) ? 1u : 0u; mine = (j == x) ? c : mine; }
        if (sum == G) break;
        __builtin_amdgcn_s_sleep(1);
        if ((++sp & 255u) == 0u) { if (xb_ld(&bar[XB_TMO])) break; if (sp > XB_SPIN_CAP) { atomicAdd(&bar[XB_TMO], 1u); break; } }
    }
    nloc = mine > 0u ? mine : 1u; nx = cnt > 0u ? cnt : 1u;
}

__device__ __forceinline__ void xcd_barrier(const XcdBarrier& b) {
    asm volatile("s_waitcnt vmcnt(0)" ::: "memory");
    __syncthreads();
    if (threadIdx.x == 0) {
        unsigned* bar = b.bar;
        __builtin_amdgcn_s_waitcnt(0);
        unsigned nloc = b.st[0], nx = b.st[1];
        if (nloc == 0u) { xcd_barrier_complete(bar, b.x, nloc, nx); b.st[0] = nloc; b.st[1] = nx; }
        const unsigned old = xb_add(&bar[XB_XSUB(b.x)], 1u);
        const unsigned gen = old / nloc;
        if (old + 1u == (gen + 1u) * nloc) {
            __builtin_amdgcn_fence(__ATOMIC_RELEASE, "agent");
            asm volatile("s_waitcnt vmcnt(0)" ::: "memory");
            const unsigned og = xb_add(&bar[XB_TOP], 1u);
            const unsigned tg = og / nx;
            if (og + 1u == (tg + 1u) * nx) xb_add(&bar[XB_TOPGEN], 1u);
            else XB_SPIN(xb_ld(&bar[XB_TOPGEN]) == tg, bar);
            __builtin_amdgcn_fence(__ATOMIC_ACQUIRE, "agent");
            xb_add(&bar[XB_XGEN(b.x)], 1u);
            asm volatile("s_waitcnt vmcnt(0)" ::: "memory");
        } else {
            XB_SPIN(xb_ld(&bar[XB_XGEN(b.x)]) == gen, bar);
            __builtin_amdgcn_fence(__ATOMIC_ACQUIRE, "agent");
            asm volatile("s_waitcnt vmcnt(0)" ::: "memory");
        }
    }
    __syncthreads();
}

struct Args { const float* in[18]; float* out; unsigned char* ws; int ph_lo, ph_hi; };
__global__ void __launch_bounds__(NTHR, 2) mk_fwd(Args args) {
    extern __shared__ __attribute__((aligned(16))) unsigned char lds[];
    cg::grid_group grid = cg::this_grid();
    PG8_LAS unsigned char* lds3 = (PG8_LAS unsigned char*)lds;
    const int tid = threadIdx.x, lane = tid & 63, wave = __builtin_amdgcn_readfirstlane(tid >> 6);
    const int G = gridDim.x, bx = blockIdx.x;
    unsigned char* ws = args.ws;
    const float* x = args.in[0]; float* out = args.out;
    float* rstd0 = (float*)(ws + WS_RSTD0); float* ss1 = (float*)(ws + WS_SS1); float* ss2 = (float*)(ws + WS_SS2); float* ss3 = (float*)(ws + WS_SS3); float* rstdm = (float*)(ws + WS_RSTDM);
    bf16* PWt = (bf16*)(ws + WS_PWT);
    bf16* Win_t = (bf16*)(ws + WS_WIN); bf16* Wout_t = (bf16*)(ws + WS_WOUT); bf16* Wq_t = (bf16*)(ws + WS_WQ); bf16* Wkv_t = (bf16*)(ws + WS_WKV); bf16* Wo_t = (bf16*)(ws + WS_WO); bf16* Wup_t = (bf16*)(ws + WS_WUP); bf16* Wdn_t = (bf16*)(ws + WS_WDN);
    bf16* Kb = (bf16*)(ws + WS_KB); bf16* Vtg = (bf16*)(ws + WS_VT); bf16* memb = (bf16*)(ws + WS_MEMB);
    bf16* bufA = (bf16*)(ws + WS_BUFA); bf16* Ub = (bf16*)(ws + WS_U); bf16* Hb = (bf16*)(ws + WS_U + 64 * MiB); float* LFb = (float*)(ws + WS_LF); bf16* Ymix = (bf16*)(ws + WS_YMIX);
    bf16* Qx = (bf16*)(ws + WS_QX); bf16* Obuf = (bf16*)(ws + WS_OB); bf16* A2 = (bf16*)(ws + WS_A2);
    const int lo = args.ph_lo, hi = args.ph_hi;
    volatile LAS unsigned* bst = (volatile LAS unsigned*)(lds3 + (LDS_BYTES - 16));
    if (tid < 2) bst[tid] = 0u;
    __syncthreads();
    XcdBarrier xbar; xbar.bar = (unsigned*)ws; xbar.x = xb_xcc_id(); xbar.st = bst;
    if (bx == 0) for (int i = tid; i < XCD_BAR_WORDS; i += NTHR) ((unsigned*)ws)[i] = 0u;
#ifdef DBG_STOP
#define PH_MASK ((2 << DBG_STOP) - 1)
#endif
#ifndef PH_MASK
#define PH_MASK 0x3ff
#endif
#define IN(k) (((PH_MASK >> (k)) & 1) && lo <= (k) && (k) < hi)
#define SEAM(k) do { if (lo <= (k) && (k) + 1 < hi) { if ((k) != 0) { xcd_barrier(xbar); } else { asm volatile("s_waitcnt vmcnt(0) lgkmcnt(0)" ::: "memory"); grid.sync(); __builtin_amdgcn_fence(__ATOMIC_ACQUIRE, "agent"); asm volatile("s_waitcnt vmcnt(0)" ::: "memory"); __builtin_amdgcn_s_barrier(); asm volatile("" ::: "memory"); } } } while (0)

    if (IN(0)) {
        float* scr = (float*)(lds + wave * 16384);
        const int gw = bx * NWAVES + wave, NGW = G * NWAVES;
        constexpr int I_IN = (D / 64) * (INC / 32), I_SQ = (D / 64) * (D / 32), I_KV = (D / 64) * (2 * D / 32), I_UP = (D / 64) * (FF / 32), I_DN = (FF / 64) * (D / 32);
        constexpr int NITEMS = I_IN + 3 * I_SQ + I_KV + I_UP + I_DN;
        for (int it = gw; it < NITEMS; it += NGW) {
            int r = it;
            if (r < I_IN) { if (r % (INC / 32) >= 16) p0_transpose_item(args.in[3], D, INC, args.in[2], Win_t, scr, r, lane); continue; } r -= I_IN;
            if (r < I_SQ) { p0_transpose_item(args.in[8], D, D, nullptr, Wout_t, scr, r, lane); continue; } r -= I_SQ;
            if (r < I_SQ) { p0_transpose_item(args.in[11], D, D, args.in[9], Wq_t, scr, r, lane); continue; } r -= I_SQ;
            if (r < I_KV) { p0_transpose_item(args.in[12], D, 2 * D, args.in[10], Wkv_t, scr, r, lane); continue; } r -= I_KV;
            if (r < I_SQ) { p0_transpose_item(args.in[13], D, D, nullptr, Wo_t, scr, r, lane); continue; } r -= I_SQ;
            if (r < I_UP) { p0_transpose_item(args.in[15], D, FF, args.in[14], Wup_t, scr, r, lane); continue; } r -= I_UP;
            p0_transpose_item(args.in[16], FF, D, nullptr, Wdn_t, scr, r, lane);
        }
        for (int m = gw; m < M; m += NGW) p0_row(x + (size_t)m * D, bufA + (size_t)m * D, rstd0 + m, lane);
        for (int m = gw; m < MROWS; m += NGW) p0_row(args.in[1] + (size_t)m * D, memb + (size_t)m * D, rstdm + m, lane);
        const int gt = bx * NTHR + tid, NGT = G * NTHR;
        (void)gt; (void)NGT;
        __syncthreads();
        { float* Af = (float*)lds; float* Pf = (float*)(lds + 16 * 129 * 4 + 64);
          for (int tile = bx; tile < 256; tile += G) { const int g = tile & 3, k0 = (tile >> 2) * 16;
              for (int i = 0; i < 4; ++i) { const int idx = tid + NTHR * i, k = idx >> 7, c = idx & 127; Af[k * 129 + c] = args.in[3][(size_t)(k0 + k) * INC + g * 128 + c] * args.in[2][k0 + k]; }
              for (int i = 0; i < 32; ++i) { const int idx = tid + NTHR * i; Pf[idx] = args.in[4][g * 16384 + idx]; }
              __syncthreads();
              const int d = tid & 127, kq = tid >> 7; float acc[4];
#pragma unroll
              for (int i = 0; i < 4; ++i) acc[i] = 0.f;
              for (int c = 0; c < 128; ++c) { const float p = Pf[c * 128 + d];
#pragma unroll
                  for (int i = 0; i < 4; ++i) acc[i] += Af[(kq * 4 + i) * 129 + c] * p; }
              const float sc = args.in[5][g * 128 + d];
              u32x2 o0; o0.x = pk2(acc[0] * sc, acc[1] * sc); o0.y = pk2(acc[2] * sc, acc[3] * sc);
              *(u32x2*)(Win_t + (size_t)(g * 128 + d) * D + k0 + kq * 4) = o0;
              __syncthreads(); } }
    }
    SEAM(0);
    if (tid == 0) (void)xb_add(&xbar.bar[XB_XCNT(xbar.x)], 1u);
    if (IN(1)) {
        pg8::Gemm g{bufA, Win_t, M, INC, D}; pg8::StaticOrder S; S.init(M, INC, G, bx);
        pg8::EpiU E{Ub, Hb, LFb, rstd0, args.in[6]};
        pg8::gemm_phase<pg8::EpiU, pg8::StaticOrder, true, true>(lds3, g, S, E);
    }
    SEAM(1);
    if (IN(2)) {
        float* SLb = (float*)(ws + WS_SL); float* DLb = (float*)(ws + WS_DL);
        if ((bx & 3) != 3) hgrn_unit<true>(lds, bx >> 4, (bx >> 2) & 3, bx & 3, Hb, LFb, args.in[7], Ymix, SLb, DLb);
        {
            const int gw = bx * NWAVES + wave, NGW = G * NWAVES;
            for (int wu = gw; wu < (M / 16) * 4; wu += NGW) { const int g = wu & 3, tb = wu >> 2;
                if (g == 0) pool_wave_unit<0>(tb, Ub, Ymix, lane); else if (g == 1) pool_wave_unit<1>(tb, Ub, Ymix, lane); else if (g == 2) pool_wave_unit<2>(tb, Ub, Ymix, lane); else pool_wave_unit<3>(tb, Ub, Ymix, lane); }
            __syncthreads();
            if ((bx & 3) == 3) {
            const int cc = bx >> 2;
            { pg8::Gemm g{memb, Wkv_t, MROWS, D, D}; pg8::StaticOrder S; S.init(MROWS, D, G, cc);
              pg8::EpiScale<false, false, false> E{Kb, D, rstdm, 0.0625f * 1.44269504088896f};
              pg8::gemm_phase<pg8::EpiScale<false, false, false>, pg8::StaticOrder, true, true>(lds3, g, S, E); }
            { pg8::Gemm g{Wkv_t + (size_t)D * D, memb, D, MROWS, D}; pg8::StaticOrder S; S.init(D, MROWS, G, cc);
              pg8::EpiScale<true, false, false> E{Vtg, MROWS, rstdm, 1.0f};
              pg8::gemm_phase<pg8::EpiScale<true, false, false>, pg8::StaticOrder, true, true>(lds3, g, S, E); }
            }
        }
        xcd_barrier(xbar);
        hgrn_unit<false>(lds, bx >> 4, (bx >> 2) & 3, bx & 3, Hb, LFb, args.in[7], Ymix, SLb, DLb);
    }
    SEAM(2);
    if (IN(3)) {
        pg8::Gemm g{Ymix, Wout_t, M, D, D}; pg8::StaticOrder S; S.init(M, D, G, bx);
        pg8::EpiResid<false, false, true> E{x, nullptr, bufA, ss1};
        pg8::gemm_phase<pg8::EpiResid<false, false, true>, pg8::StaticOrder, true, true>(lds3, g, S, E);
    }
    SEAM(3);
    if (IN(4)) {
        pg8::Gemm g{bufA, Wq_t, M, D, D}; pg8::StaticOrder S; S.init(M, D, G, bx);
        PG8_LAS float* qtab = (PG8_LAS float*)(lds3 + 131072);
        { pg8::Unit uu;
          for (int i = 0; i < 4; ++i) if (S.next(i, uu)) { for (int r = tid; r < 256; r += NTHR) { const f32x4* sp = (const f32x4*)(ss1 + (size_t)(uu.pm * 256 + r) * 16); const f32x4 p0 = sp[0], p1 = sp[1], p2 = sp[2], p3 = sp[3];
              const float ssum = ((p0[0] + p0[1]) + (p0[2] + p0[3])) + ((p1[0] + p1[1]) + (p1[2] + p1[3])) + ((p2[0] + p2[1]) + (p2[2] + p2[3])) + ((p3[0] + p3[1]) + (p3[2] + p3[3]));
              qtab[((uu.pm >> 3) & 3) * 256 + r] = rsqrtf(ssum * (1.0f / 1024.0f) + 1e-6f); } }
          __syncthreads(); }
        pg8::EpiQ E{Qx, qtab};
        pg8::gemm_phase<pg8::EpiQ, pg8::StaticOrder, true, true>(lds3, g, S, E);
    }
    SEAM(4);
    if (IN(5)) {
        attn_wg(lds, bx, Qx, Kb, Vtg, Obuf);
    }
    SEAM(5);
    if (IN(6)) {
        pg8::Gemm g{Obuf, Wo_t, M, D, D}; pg8::StaticOrder S; S.init(M, D, G, bx);
        pg8::EpiResid<true, false, true> E{bufA, nullptr, bufA, ss2};
        pg8::gemm_phase<pg8::EpiResid<true, false, true>, pg8::StaticOrder, true, true>(lds3, g, S, E);
    }
    SEAM(6);
    if (IN(7)) {
        pg8::Gemm g{bufA, Wup_t, M, FF, D}; pg8::StaticOrder S; S.init(M, FF, G, bx);
        PG8_LAS float* utab = (PG8_LAS float*)(lds3 + 131072);
        { pg8::Unit uu;
          for (int i = 0; i < 16; i += 4) if (S.next(i, uu)) { for (int r = tid; r < 256; r += NTHR) { const f32x4* sp = (const f32x4*)(ss2 + (size_t)(uu.pm * 256 + r) * 16); const f32x4 p0 = sp[0], p1 = sp[1], p2 = sp[2], p3 = sp[3];
              const float ssum = ((p0[0] + p0[1]) + (p0[2] + p0[3])) + ((p1[0] + p1[1]) + (p1[2] + p1[3])) + ((p2[0] + p2[1]) + (p2[2] + p2[3])) + ((p3[0] + p3[1]) + (p3[2] + p3[3]));
              utab[((uu.pm >> 3) & 3) * 256 + r] = rsqrtf(ssum * (1.0f / 1024.0f) + 1e-6f); } }
          __syncthreads(); }
        pg8::EpiUp E{A2, ss2, utab, {0.f, 0.f, 0.f, 0.f, 0.f, 0.f, 0.f, 0.f}, -1};
        pg8::gemm_phase<pg8::EpiUp, pg8::StaticOrder, true, true>(lds3, g, S, E);
    }
    SEAM(7);
    if (IN(8)) {
        pg8::Gemm g{A2, Wdn_t, M, D, FF}; pg8::StaticOrder S; S.init(M, D, G, bx);
        pg8::EpiResid<true, false, true> E{bufA, nullptr, bufA, ss3};
        pg8::gemm_phase<pg8::EpiResid<true, false, true>, pg8::StaticOrder, true, true>(lds3, g, S, E);
    }
    SEAM(8);
    if (IN(9)) {
        const int gw = bx * NWAVES + wave, NGW = G * NWAVES;
        const f32x4* gf = (const f32x4*)args.in[17] + lane;
        f32x4 gv[4];
#pragma unroll
        for (int j = 0; j < 4; ++j) gv[j] = gf[64 * j];
        for (int m = gw; m < M; m += NGW) { f32x4* o = (f32x4*)(out + (size_t)m * D) + lane; const u32x2* hb = (const u32x2*)(bufA + (size_t)m * D) + lane;
            float sv = (lane < 16) ? ss3[(size_t)m * 16 + lane] : 0.f; sv += __shfl_xor(sv, 1); sv += __shfl_xor(sv, 2); sv += __shfl_xor(sv, 4); sv += __shfl_xor(sv, 8); sv = __shfl(sv, 0); const float rs = rsqrtf(sv * (1.0f / D) + EPS);
#pragma unroll
            for (int j = 0; j < 4; ++j) { const u32x2 w = hb[64 * j]; const f32x4 hv = {bflo(w.x), bfhi(w.x), bflo(w.y), bfhi(w.y)}; o[64 * j] = hv * rs * gv[j]; } }
    }
#ifdef DBG_STOP
    { asm volatile("s_waitcnt vmcnt(0) lgkmcnt(0)" ::: "memory"); grid.sync(); __builtin_amdgcn_fence(__ATOMIC_ACQUIRE, "agent"); asm volatile("s_waitcnt vmcnt(0)" ::: "memory");
      const size_t gt = (size_t)bx * NTHR + tid, NGT = (size_t)G * NTHR;
      for (size_t i = gt; i < (size_t)M * D; i += NGT) { const size_t m = i >> 10, c = i & 1023; float v = 0.f;
          if (DBG_STOP == 0) v = bflo(bufA[i]) + rstd0[m] + bflo(Win_t[i % (2560u * 1024u)]) + bflo(Wup_t[i % (4096u * 1024u)]) + bflo(Wdn_t[(i * 7) % (4096u * 1024u)]) + bflo(Wkv_t[i % (2048u * 1024u)]) + bflo(Wq_t[i % (1024u * 1024u)]) + bflo(Wo_t[i % (1024u * 1024u)]) + bflo(Wout_t[i % (1024u * 1024u)]) + bflo(memb[i % (4096u * 1024u)]) + rstdm[m & 4095];
          if (DBG_STOP == 1) v = bflo(Ub[m * 512 + (c & 511)]) + bflo(Hb[i]) + bflo(Hb[i + 67108864]) + LFb[m * 512 + (c & 511)];
          if (DBG_STOP == 2) { if (DBG_SUB == 0) v = bflo(Ymix[m * D + (c & 511)]); if (DBG_SUB == 1) v = bflo(Ymix[m * D + 512 + (c & 511)]); if (DBG_SUB == 2) v = bflo(Kb[(m & 4095) * D + c]); if (DBG_SUB == 3) v = bflo(Vtg[c * MROWS + (m & 4095)]); if (DBG_SUB == 4) v = bflo(Ymix[i]) + bflo(Kb[(m & 4095) * D + c]) + bflo(Vtg[c * MROWS + (m & 4095)]); }
          if (DBG_STOP == 3) v = out[i] + bflo(bufA[i]) + ss1[m * 16 + (c & 15)];
          if (DBG_STOP == 4) v = bflo(Qx[i]);
          if (DBG_STOP == 5) v = bflo(Obuf[i]);
          if (DBG_STOP == 6) v = out[i] + bflo(bufA[i]) + ss2[m * 16 + (c & 15)];
          if (DBG_STOP == 7) v = bflo(A2[m * FF + c]) + bflo(A2[m * FF + 1024 + c]) + bflo(A2[m * FF + 2048 + c]) + bflo(A2[m * FF + 3072 + c]);
          if (DBG_STOP == 8) v = out[i] + ss3[m * 16 + (c & 15)];
          out[i] = v; } }
#endif
#undef IN
#undef SEAM
}

extern "C" void kernel_launch(void* const* d_in, const int* in_sizes, int n_in, void* d_out, int out_size, void* d_ws, size_t ws_size, hipStream_t stream) {
    static int grid = 0;
    if (grid == 0) {
        if (n_in != 18 || in_sizes[0] != M * D || out_size != M * D || ws_size < WS_END) { fprintf(stderr, "kernel_launch: unexpected shapes (n_in %d, in0 %d, out %d, ws %zu); nothing launched\n", n_in, n_in > 0 ? in_sizes[0] : -1, out_size, ws_size); grid = -1; return; }
        int dev = 0, cus = 0, per_cu = 0;
        if (hipGetDevice(&dev) != hipSuccess || hipDeviceGetAttribute(&cus, hipDeviceAttributeMultiprocessorCount, dev) != hipSuccess) { grid = -1; return; }
        if (hipFuncSetAttribute((const void*)mk_fwd, hipFuncAttributeMaxDynamicSharedMemorySize, LDS_BYTES) != hipSuccess) { fprintf(stderr, "kernel_launch: hipFuncSetAttribute failed\n"); grid = -1; return; }
        if (hipOccupancyMaxActiveBlocksPerMultiprocessor(&per_cu, (const void*)mk_fwd, NTHR, LDS_BYTES) != hipSuccess || per_cu < 1) { fprintf(stderr, "kernel_launch: occupancy query failed (%d)\n", per_cu); (void)hipGetLastError(); grid = -1; return; }
        grid = cus * per_cu;
        if (grid > 256) grid = 256;
        if (grid != 256) { fprintf(stderr, "kernel_launch: this kernel needs exactly 256 co-resident workgroups (got %d); nothing launched\n", grid); grid = -1; return; }
    }
    if (grid < 0) return;
    Args a{};
    for (int i = 0; i < 18; ++i) a.in[i] = (const float*)d_in[i];
    a.out = (float*)d_out; a.ws = (unsigned char*)d_ws;
#if MK_N_LAUNCHES == 1
    a.ph_lo = 0; a.ph_hi = NPHASE;
    void* kargs[] = {&a};
    hipError_t e = hipLaunchCooperativeKernel((const void*)mk_fwd, dim3(grid), dim3(NTHR), kargs, LDS_BYTES, stream);
    if (e != hipSuccess) fprintf(stderr, "kernel_launch: cooperative launch failed: %s (grid %d)\n", hipGetErrorString(e), grid);
#else
    for (int p = 0; p < NPHASE; ++p) { a.ph_lo = p; a.ph_hi = p + 1; hipLaunchKernelGGL(mk_fwd, dim3(grid), dim3(NTHR), LDS_BYTES, stream, a); }
#endif
}
```
